# Optimizing an MI355X kernel written in HIP

```python
import math
import jax, jax.numpy as jnp
from jax import lax
import numpy as np

D_MODEL = 4096
BATCH = 16
SEQ = 256
DEPTH = 1
DEC_BATCH = 2
DEC_SEQ = 1024
PAST_LEN = 512

GRID_W = 64
N_HEADS = 16
NOPE_DIM = 128
ROPE_DIM = 64
V_DIM = 128
QK_DIM = NOPE_DIM + ROPE_DIM
Q_LORA = D_MODEL // 4
KV_LORA = D_MODEL // 8
MLA_W = N_HEADS * V_DIM
ROPE_BASE = 10000.0
AXIS_PAIRS = ROPE_DIM // 4
Q_BLOCK = 128
S5_W = D_MODEL // 2
S5_GROUP_CH = 16
S5_GROUPS = S5_W // S5_GROUP_CH
S5_STATE = 64
N_DIR = 2
ALPHA = (2.0 * DEPTH) ** 0.25
BETA = (8.0 * DEPTH) ** -0.25
LN_EPS = 1e-6
IN_SEGMENTS = (Q_LORA, KV_LORA, ROPE_DIM, MLA_W, S5_W, S5_W, D_MODEL, D_MODEL)
IN_COLS = sum(IN_SEGMENTS)

kernel_name = "hybrid_mla_s5_diffusion_step"


def _split_points():
    return [int(v) for v in np.cumsum(IN_SEGMENTS)[:-1]]


def _layernorm(x):
    xf = x.astype(jnp.float32)
    mu = jnp.mean(xf, axis=-1, keepdims=True)
    var = jnp.mean(jnp.square(xf - mu), axis=-1, keepdims=True)
    return ((xf - mu) * lax.rsqrt(var + LN_EPS)).astype(x.dtype)


def _rmsnorm(x, g):
    xf = x.astype(jnp.float32)
    y = xf * lax.rsqrt(jnp.mean(jnp.square(xf), axis=-1, keepdims=True) + LN_EPS)
    return y.astype(x.dtype) * g


def _axial_tables(n_tokens):
    rows = n_tokens // GRID_W
    t = jnp.arange(rows * GRID_W)
    row = (t // GRID_W).astype(jnp.float32)
    col = (t % GRID_W).astype(jnp.float32)
    inv = jnp.power(ROPE_BASE, -jnp.arange(AXIS_PAIRS, dtype=jnp.float32) / AXIS_PAIRS)
    ang_r = row[:, None] * inv[None, :]
    ang_c = col[:, None] * inv[None, :]
    return (jnp.cos(ang_r), jnp.sin(ang_r), jnp.cos(ang_c), jnp.sin(ang_c))


def _rot_half(x, cos, sin):
    x1, x2 = jnp.split(x, 2, axis=-1)
    return jnp.concatenate([x1 * cos - x2 * sin, x2 * cos + x1 * sin], axis=-1)


def _axial_rope(x, tabs):
    cr, sr, cc, sc = [t.astype(x.dtype) for t in tabs]
    xr, xc = jnp.split(x, 2, axis=-1)
    return jnp.concatenate([_rot_half(xr, cr, sr), _rot_half(xc, cc, sc)], axis=-1)


def _mla_attend(q_nope, q_pe, k_nope, k_pe, v):
    B, Lq = q_nope.shape[0], q_nope.shape[1]
    nb = Lq // Q_BLOCK
    scale = QK_DIM ** -0.5

    def block(args):
        qn, qp = args
        s = jnp.einsum("bqhd,bkhd->bhqk", qn, k_nope) + jnp.einsum("bqhr,bkr->bhqk", qp, k_pe)
        p = jax.nn.softmax(s.astype(jnp.float32) * scale, axis=-1).astype(v.dtype)
        return jnp.einsum("bhqk,bkhd->bqhd", p, v)

    qn_b = q_nope.reshape(B, nb, Q_BLOCK, N_HEADS, NOPE_DIM).swapaxes(0, 1)
    qp_b = q_pe.reshape(B, nb, Q_BLOCK, N_HEADS, ROPE_DIM).swapaxes(0, 1)
    out = lax.map(block, (qn_b, qp_b))
    return out.swapaxes(0, 1).reshape(B, Lq, N_HEADS * V_DIM)


def _s5_discretize(a_re, a_im, log_dt, b_re, b_im):
    a_re = a_re.astype(jnp.float32)
    a_im = a_im.astype(jnp.float32)
    dt = jnp.exp(log_dt.astype(jnp.float32))[:, None]
    mag = jnp.exp(dt * a_re)
    ab_re = mag * jnp.cos(dt * a_im)
    ab_im = mag * jnp.sin(dt * a_im)
    den = jnp.square(a_re) + jnp.square(a_im)
    p_re = ab_re - 1.0
    q_re = (p_re * a_re + ab_im * a_im) / den
    q_im = (ab_im * a_re - p_re * a_im) / den
    b_re = b_re.astype(jnp.float32)
    b_im = b_im.astype(jnp.float32)
    bb_re = q_re[..., None] * b_re - q_im[..., None] * b_im
    bb_im = q_re[..., None] * b_im + q_im[..., None] * b_re
    return ab_re, ab_im, bb_re, bb_im


def _affine_combine(e1, e2):
    a1r, a1i, b1r, b1i = e1
    a2r, a2i, b2r, b2i = e2
    return (a2r * a1r - a2i * a1i, a2r * a1i + a2i * a1r,
            a2r * b1r - a2i * b1i + b2r, a2r * b1i + a2i * b1r + b2i)


def _s5_scan(u, h0, ab_re, ab_im, bb_re, bb_im, c_re, c_im, reverse):
    bu_re = jnp.einsum("blgc,gnc->blgn", u, bb_re)
    bu_im = jnp.einsum("blgc,gnc->blgn", u, bb_im)
    a_re = jnp.broadcast_to(ab_re, bu_re.shape)
    a_im = jnp.broadcast_to(ab_im, bu_im.shape)
    pa_re, pa_im, x_re, x_im = lax.associative_scan(
        _affine_combine, (a_re, a_im, bu_re, bu_im), reverse=reverse, axis=1)
    if h0 is None:
        idx = 0 if reverse else -1
        final = (x_re[:, idx], x_im[:, idx])
    else:
        h_re = h0[0][:, None]
        h_im = h0[1][:, None]
        x_re, x_im = (x_re + pa_re * h_re - pa_im * h_im,
                      x_im + pa_re * h_im + pa_im * h_re)
        final = None
    y = (jnp.einsum("blgn,gcn->blgc", x_re, c_re)
         - jnp.einsum("blgn,gcn->blgc", x_im, c_im))
    return y, final


def _s5_branch(u, h0, a_re, a_im, log_dt, b_re, b_im, c_re, c_im, d_skip, w_glu, b_glu):
    B, L, W = u.shape
    uf = u.astype(jnp.float32)
    ug = uf.reshape(B, L, S5_GROUPS, S5_GROUP_CH)
    y = d_skip.astype(jnp.float32) * uf
    fin_re, fin_im = [], []
    for d in range(N_DIR):
        ab_re, ab_im, bb_re, bb_im = _s5_discretize(a_re[d], a_im[d], log_dt[d], b_re[d], b_im[d])
        h0_d = None if h0 is None else (h0[0][:, d].astype(jnp.float32), h0[1][:, d].astype(jnp.float32))
        y_d, fin = _s5_scan(ug, h0_d, ab_re, ab_im, bb_re, bb_im,
                            c_re[d].astype(jnp.float32), c_im[d].astype(jnp.float32), reverse=(d == 1))
        y = y + y_d.reshape(B, L, W)
        if fin is not None:
            fin_re.append(fin[0])
            fin_im.append(fin[1])
    y = jax.nn.gelu(y).astype(u.dtype)
    y = y * jax.nn.sigmoid(y @ w_glu + b_glu)
    if h0 is None:
        return y, (jnp.stack(fin_re, axis=1).astype(u.dtype), jnp.stack(fin_im, axis=1).astype(u.dtype))
    return y, None


def _layer(x, cond, ctx, w_ada, b_ada, w_in, g_qn, w_uq, g_kvn, w_ukv,
           s5_a_re, s5_a_im, s5_log_dt, s5_b_re, s5_b_im, s5_c_re, s5_c_im, s5_d,
           w_glu, b_glu, w_pa, w_pb, w_o, ln_g, ln_b):
    B, L, _ = x.shape
    mod = (jax.nn.silu(cond) @ w_ada + b_ada).reshape(-1, 1, 3 * D_MODEL)
    shift, scale, gate = jnp.split(mod, 3, axis=-1)
    h = _layernorm(x) * (1.0 + scale) + shift
    proj = h @ w_in
    cq, ckv_raw, kpe, za, ub, zb, ga, gb = jnp.split(proj, _split_points(), axis=-1)
    ckv = _rmsnorm(ckv_raw, g_kvn)
    q = (_rmsnorm(cq, g_qn) @ w_uq).reshape(B, L, N_HEADS, QK_DIM)
    q_nope, q_pe = q[..., :NOPE_DIM], q[..., NOPE_DIM:]
    kv = (ckv @ w_ukv).reshape(B, L, N_HEADS, NOPE_DIM + V_DIM)
    k_nope, v = kv[..., :NOPE_DIM], kv[..., NOPE_DIM:]
    s5_params = (s5_a_re, s5_a_im, s5_log_dt, s5_b_re, s5_b_im, s5_c_re, s5_c_im, s5_d, w_glu, b_glu)
    if ctx is None:
        attn = _mla_attend(q_nope, q_pe, k_nope, kpe, v)
        s5_y, s5_fin = _s5_branch(ub, None, *s5_params)
        new_state = (ckv, kpe, s5_fin[0], s5_fin[1])
    else:
        c_ckv, c_kpe, s_re, s_im = ctx
        tabs = _axial_tables(L)
        q_pe = _axial_rope(q_pe, [t[:, None, :] for t in tabs])
        k_pe = _axial_rope(kpe, tabs)
        P = c_ckv.shape[1]
        ckv_up = (c_ckv @ w_ukv).reshape(B, P, N_HEADS, NOPE_DIM + V_DIM)
        k_all = jnp.concatenate([k_nope, ckv_up[..., :NOPE_DIM]], axis=1)
        v_all = jnp.concatenate([v, ckv_up[..., NOPE_DIM:]], axis=1)
        kpe_all = jnp.concatenate([k_pe, c_kpe], axis=1)
        attn = _mla_attend(q_nope, q_pe, k_all, kpe_all, v_all)
        s5_y, _ = _s5_branch(ub, (s_re, s_im), *s5_params)
        new_state = None
    branch_a = attn * jax.nn.silu(za)
    branch_b = s5_y * jax.nn.silu(zb)
    merged = jax.nn.sigmoid(ga) * (branch_a @ w_pa) + jax.nn.sigmoid(gb) * (branch_b @ w_pb)
    y = gate * (merged @ w_o)
    x = _layernorm(ALPHA * x + y) * ln_g + ln_b
    return x, new_state


def setup_inputs(seed: int = 0) -> dict:
    key = jax.random.key(seed)
    ks = jax.random.split(key, 32)
    f32 = jnp.float32

    def nrm(k, shape, s):
        return jax.random.normal(k, shape, f32) * s

    n_idx = jnp.arange(S5_STATE, dtype=f32)
    return {
        "x_prompt": nrm(ks[0], (BATCH, SEQ, D_MODEL), 1.0),
        "x_sample": nrm(ks[1], (DEC_BATCH, DEC_SEQ, D_MODEL), 1.0),
        "cache_ckv": nrm(ks[2], (DEC_BATCH, DEPTH, PAST_LEN, KV_LORA), 1.0),
        "cache_kpe": nrm(ks[3], (DEC_BATCH, DEPTH, PAST_LEN, ROPE_DIM), 1.0),
        "state_s5_re": nrm(ks[4], (DEC_BATCH, DEPTH, N_DIR, S5_GROUPS, S5_STATE), 0.3),
        "state_s5_im": nrm(ks[5], (DEC_BATCH, DEPTH, N_DIR, S5_GROUPS, S5_STATE), 0.3),
        "c": nrm(ks[6], (DEC_BATCH, D_MODEL), 1.0),
        "c_ctx": nrm(ks[7], (D_MODEL,), 1.0),
        "w_ada": nrm(ks[8], (DEPTH, D_MODEL, 3 * D_MODEL), 0.5 * D_MODEL ** -0.5),
        "b_ada": nrm(ks[9], (DEPTH, 3 * D_MODEL), 0.02),
        "w_in": nrm(ks[10], (DEPTH, D_MODEL, IN_COLS), D_MODEL ** -0.5),
        "g_qn": 1.0 + nrm(ks[11], (DEPTH, Q_LORA), 0.02),
        "w_uq": nrm(ks[12], (DEPTH, Q_LORA, N_HEADS * QK_DIM), Q_LORA ** -0.5),
        "g_kvn": 1.0 + nrm(ks[13], (DEPTH, KV_LORA), 0.02),
        "w_ukv": nrm(ks[14], (DEPTH, KV_LORA, N_HEADS * (NOPE_DIM + V_DIM)), KV_LORA ** -0.5),
        "s5_a_re": -0.5 + nrm(ks[15], (DEPTH, N_DIR, S5_GROUPS, S5_STATE), 0.01),
        "s5_a_im": math.pi * n_idx + nrm(ks[16], (DEPTH, N_DIR, S5_GROUPS, S5_STATE), 0.01),
        "s5_log_dt": jax.random.uniform(ks[17], (DEPTH, N_DIR, S5_GROUPS), f32,
                                        math.log(1e-3), math.log(1e-1)),
        "s5_b_re": nrm(ks[18], (DEPTH, N_DIR, S5_GROUPS, S5_STATE, S5_GROUP_CH), (2.0 * S5_GROUP_CH) ** -0.5),
        "s5_b_im": nrm(ks[19], (DEPTH, N_DIR, S5_GROUPS, S5_STATE, S5_GROUP_CH), (2.0 * S5_GROUP_CH) ** -0.5),
        "s5_c_re": nrm(ks[20], (DEPTH, N_DIR, S5_GROUPS, S5_GROUP_CH, S5_STATE), (2.0 * S5_STATE) ** -0.5),
        "s5_c_im": nrm(ks[21], (DEPTH, N_DIR, S5_GROUPS, S5_GROUP_CH, S5_STATE), (2.0 * S5_STATE) ** -0.5),
        "s5_d": nrm(ks[22], (DEPTH, S5_W), 1.0),
        "w_glu": nrm(ks[23], (DEPTH, S5_W, S5_W), S5_W ** -0.5),
        "b_glu": nrm(ks[24], (DEPTH, S5_W), 0.02),
        "w_pa": nrm(ks[25], (DEPTH, MLA_W, D_MODEL), BETA * MLA_W ** -0.5),
        "w_pb": nrm(ks[26], (DEPTH, S5_W, D_MODEL), BETA * S5_W ** -0.5),
        "w_o": nrm(ks[27], (DEPTH, D_MODEL, D_MODEL), BETA * D_MODEL ** -0.5),
        "ln_g": 1.0 + nrm(ks[28], (DEPTH, D_MODEL), 0.02),
        "ln_b": nrm(ks[29], (DEPTH, D_MODEL), 0.02),
    }


def reference(x_prompt, x_sample, cache_ckv, cache_kpe, state_s5_re, state_s5_im, c, c_ctx,
              w_ada, b_ada, w_in, g_qn, w_uq, g_kvn, w_ukv,
              s5_a_re, s5_a_im, s5_log_dt, s5_b_re, s5_b_im, s5_c_re, s5_c_im, s5_d,
              w_glu, b_glu, w_pa, w_pb, w_o, ln_g, ln_b):
    weights = (w_ada, b_ada, w_in, g_qn, w_uq, g_kvn, w_ukv,
               s5_a_re, s5_a_im, s5_log_dt, s5_b_re, s5_b_im, s5_c_re, s5_c_im, s5_d,
               w_glu, b_glu, w_pa, w_pb, w_o, ln_g, ln_b)
    yp = x_prompt
    ys = x_sample
    ckv_l, kpe_l, sre_l, sim_l = [], [], [], []
    for l in range(DEPTH):
        lw = [w[l] for w in weights]
        yp, st = _layer(yp, c_ctx, None, *lw)
        ckv_l.append(st[0])
        kpe_l.append(st[1])
        sre_l.append(st[2])
        sim_l.append(st[3])
        ctx = (cache_ckv[:, l], cache_kpe[:, l], state_s5_re[:, l], state_s5_im[:, l])
        ys, _ = _layer(ys, c, ctx, *lw)
    new_cache_ckv = jnp.stack(ckv_l, axis=1)
    new_cache_kpe = jnp.stack(kpe_l, axis=1)
    new_state_s5_re = jnp.stack(sre_l, axis=1)
    new_state_s5_im = jnp.stack(sim_l, axis=1)
    return (yp, ys, new_cache_ckv, new_cache_kpe, new_state_s5_re, new_state_s5_im)
```

```cpp
#include <hip/hip_runtime.h>
#include <hip/hip_cooperative_groups.h>
#include <cstdio>
#include <cstdint>
namespace cg = cooperative_groups;
namespace pg8 {
#define PG8_LAS __attribute__((address_space(3)))
typedef unsigned short bf16_t;
typedef short bf16x8 __attribute__((ext_vector_type(8)));
typedef float f32x4 __attribute__((ext_vector_type(4)));
typedef unsigned u32x4 __attribute__((ext_vector_type(4)));
constexpr int BM = 256, BK = 64, HALF = 128, HTB = HALF * BK * 2  , STAGE_BYTES = 8 * HTB, NXCD = 8, WGM = 8;

__host__ __device__ __forceinline__ int lds_byte(int r, int c) { const int st = (r >> 4) * 2 + (c >> 5), rr = r & 15, cc = c & 31, ob = rr * 64 + cc * 2; return st * 1024 + (ob ^ (((ob >> 9) & 1) << 5)); }
__host__ __device__ __forceinline__ void stage_rc(int b, int& R, int& C) { const int st = b / 1024, sb = b % 1024, swz = sb ^ (((sb >> 9) & 1) << 5); R = (st >> 1) * 16 + swz / 64; C = (st & 1) * 32 + (swz % 64) / 2; }
__host__ __device__ __forceinline__ int perm32(int rho) { const int n = rho >> 4, i = rho & 15; return 8 * (i >> 2) + 4 * n + (i & 3); }

struct Unit { int pm, pn; };
struct Gemm { const bf16_t* A; const bf16_t* Bt; int M, N, K; };

struct StaticOrder {
    int nM, nN, nwg, G, c;
    __host__ __device__ void init(int M, int N, int G_, int c_) { nM = M / BM; nN = N / BM; nwg = nM * nN; G = G_; c = c_; }
    __host__ __device__ bool next(int i, Unit& u) const {
        const long L = (long)i * G + c; if (L >= nwg) return false;
        int wgid = (int)L; { const int q = nwg / NXCD, r = nwg % NXCD, xcd = wgid % NXCD, off = wgid / NXCD; wgid = (xcd < r ? xcd * (q + 1) : r * (q + 1) + (xcd - r) * q) + off; }
        const int nig = WGM * nN, gid = wgid / nig, fm = gid * WGM, gsz = (nM - fm) < WGM ? (nM - fm) : WGM;
        u.pm = fm + ((wgid % nig) % gsz); u.pn = (wgid % nig) / gsz; return true;
    }
    __device__ __forceinline__ void a_ready(const Unit&) const {}
    __device__ __forceinline__ void done(const Unit&) const {}
};

__device__ __forceinline__ unsigned cvt_pk_bf16(float lo, float hi) { unsigned r; asm volatile("v_cvt_pk_bf16_f32 %0, %1, %2" : "=v"(r) : "v"(lo), "v"(hi)); return r; }
typedef float f32x2 __attribute__((ext_vector_type(2)));
template <class Epi, class Sched, bool ALIGN_EPI = false, bool SP2 = false>
__device__ __forceinline__ void gemm_phase(PG8_LAS unsigned char* lds, const Gemm g, const Sched& S, const Epi& E) {
    const int tid = threadIdx.x, wid = __builtin_amdgcn_readfirstlane(tid >> 6), lane = tid & 63, wr = wid >> 2, wc = wid & 3, fr = lane & 15, fq = lane >> 4;
    const int K = g.K, nt = K / BK;
    unsigned voffA[2], voffB[2];
#pragma unroll
    for (int i = 0; i < 2; ++i) { int R, C; stage_rc(tid * 16 + i * 8192, R, C); const int Rb = Epi::PERM ? ((R & ~31) + perm32(R & 31)) : R;
        voffA[i] = (unsigned)(R * K + C) * 2u; voffB[i] = (unsigned)(Rb * K + C) * 2u; }
    const size_t kstep = (size_t)(BK * 2);
    const size_t hstep = (size_t)HALF * K * 2;
    const size_t tstep = 2 * hstep;
    const unsigned ldsw = (unsigned)wid * 1024u;
    const int aoff = lds_byte(wr * 64 + fr, fq * 8), boff = lds_byte(wc * 32 + fr, fq * 8);
#define PG8_SA(b, h) (((b) * 2 + (h)) * HTB)
#define PG8_SB(b, h) ((4 + (b) * 2 + (h)) * HTB)
#define PG8_STAGE(bufoff, gbase, voff) do { _Pragma("unroll") for (int _i = 0; _i < 2; ++_i) \
        __builtin_amdgcn_global_load_lds((const unsigned*)((const char*)(gbase) + (voff)[_i]), (PG8_LAS unsigned*)(lds + (bufoff) + ldsw + _i * 8192), 16, 0, 0); } while (0)
#define PG8_LDA(dst, b, h) do { _Pragma("unroll") for (int m = 0; m < 4; ++m) _Pragma("unroll") for (int k = 0; k < 2; ++k) dst[m][k] = *(const PG8_LAS bf16x8*)(lds + PG8_SA(b, h) + aoff + m * 2048 + k * 1024); } while (0)
#define PG8_LDB(dst, b, h) do { _Pragma("unroll") for (int n = 0; n < 2; ++n) _Pragma("unroll") for (int k = 0; k < 2; ++k) dst[n][k] = *(const PG8_LAS bf16x8*)(lds + PG8_SB(b, h) + boff + n * 2048 + k * 1024); } while (0)
#define PG8_MMA(ai, bj, At, Bt) do { __builtin_amdgcn_s_setprio(1); _Pragma("unroll") for (int m = 0; m < 4; ++m) _Pragma("unroll") for (int n = 0; n < 2; ++n) _Pragma("unroll") for (int k = 0; k < 2; ++k) \
        acc[ai][bj][m][n] = __builtin_amdgcn_mfma_f32_16x16x32_bf16(Bt[n][k], At[m][k], acc[ai][bj][m][n], 0, 0, 0); __builtin_amdgcn_s_setprio(0); } while (0)
#define PG8_WAIT_V(n) asm volatile("s_waitcnt vmcnt(" #n ")" ::: "memory")
#define PG8_WAIT_L(n) asm volatile("s_waitcnt lgkmcnt(" #n ")" ::: "memory")
#define PG8_BAR __builtin_amdgcn_s_barrier()
#define PG8_SCHED __builtin_amdgcn_sched_barrier(0)
    Unit cur, nxt; int ui = 0;
    if (!S.next(0, cur)) return;
    f32x4 acc[2][2][4][2];
#pragma unroll
    for (int a = 0; a < 2; ++a)
#pragma unroll
        for (int b = 0; b < 2; ++b)
#pragma unroll
            for (int m = 0; m < 4; ++m)
#pragma unroll
                for (int n = 0; n < 2; ++n) acc[a][b][m][n] = (f32x4){0.f, 0.f, 0.f, 0.f};
    bf16x8 At[4][2], B0[2][2], B1[2][2];
    const char* cA = (const char*)g.A + (size_t)cur.pm * tstep; const char* cB = (const char*)g.Bt + (size_t)cur.pn * tstep;
    S.a_ready(cur);
    if constexpr (SP2) {
        PG8_STAGE(PG8_SB(0, 0), cB, voffB); PG8_STAGE(PG8_SB(0, 1), cB + hstep, voffB); PG8_STAGE(PG8_SA(0, 0), cA, voffA); PG8_STAGE(PG8_SA(0, 1), cA + hstep, voffA);
        if (wr == 1) PG8_BAR;
        PG8_WAIT_V(2); PG8_BAR;
        PG8_STAGE(PG8_SB(1, 0), cB + kstep, voffB); PG8_STAGE(PG8_SA(1, 0), cA + kstep, voffA); PG8_STAGE(PG8_SB(1, 1), cB + hstep + kstep, voffB);
        PG8_WAIT_V(6); PG8_BAR;
    } else {
        PG8_STAGE(PG8_SB(0, 0), cB, voffB); PG8_STAGE(PG8_SA(0, 0), cA, voffA); PG8_STAGE(PG8_SB(0, 1), cB + hstep, voffB); PG8_STAGE(PG8_SA(0, 1), cA + hstep, voffA);
        if (wr == 1) PG8_BAR;
        PG8_WAIT_V(4); PG8_BAR;
        PG8_STAGE(PG8_SB(1, 0), cB + kstep, voffB); PG8_STAGE(PG8_SA(1, 0), cA + kstep, voffA); PG8_STAGE(PG8_SB(1, 1), cB + hstep + kstep, voffB);
        PG8_WAIT_V(6); PG8_BAR;
    }
    for (;;) {
        const bool has_next = S.next(ui + 1, nxt);
        const char* nA = has_next ? (const char*)g.A + (size_t)nxt.pm * tstep : cA; const char* nB = has_next ? (const char*)g.Bt + (size_t)nxt.pn * tstep : cB;
        for (int t = 0; t < nt; t += 2) {
            const bool last = (t == nt - 2);
            if constexpr (Epi::HAS_MID) { if (t == (nt >> 1)) E.mid(acc, cur, wr, wc, fr, fq); }
            const char* a1 = cA + (size_t)(t + 1) * kstep;
            const char* a2 = last ? nA : cA + (size_t)(t + 2) * kstep; const char* b2 = last ? nB : cB + (size_t)(t + 2) * kstep;
            const char* a3 = a2 + kstep; const char* b3 = b2 + kstep;
            if (last && has_next) S.a_ready(nxt);
            if constexpr (SP2) {
            PG8_LDB(B0, 0, 0); PG8_LDB(B1, 0, 1); PG8_SCHED; PG8_LDA(At, 0, 0); PG8_STAGE(PG8_SA(1, 1), a1 + hstep, voffA);
            PG8_WAIT_V(8); PG8_WAIT_L(0); PG8_BAR; PG8_MMA(0, 0, At, B0); PG8_MMA(0, 1, At, B1); PG8_BAR; PG8_SCHED;
            PG8_LDA(At, 0, 1); PG8_STAGE(PG8_SB(0, 0), b2, voffB); PG8_STAGE(PG8_SB(0, 1), b2 + hstep, voffB); PG8_STAGE(PG8_SA(0, 0), a2, voffA);
            PG8_WAIT_V(8); PG8_WAIT_L(0); PG8_BAR; PG8_MMA(1, 0, At, B0); PG8_MMA(1, 1, At, B1); PG8_BAR; PG8_SCHED;
            PG8_LDB(B0, 1, 0); PG8_LDB(B1, 1, 1); PG8_SCHED; PG8_LDA(At, 1, 0); PG8_STAGE(PG8_SA(0, 1), a2 + hstep, voffA);
            PG8_WAIT_V(8); PG8_WAIT_L(0); PG8_BAR; PG8_MMA(0, 0, At, B0); PG8_MMA(0, 1, At, B1); PG8_BAR; PG8_SCHED;
            PG8_LDA(At, 1, 1); PG8_STAGE(PG8_SB(1, 0), b3, voffB); PG8_STAGE(PG8_SB(1, 1), b3 + hstep, voffB); PG8_STAGE(PG8_SA(1, 0), a3, voffA);
            PG8_WAIT_V(8); PG8_WAIT_L(0); PG8_BAR; PG8_MMA(1, 0, At, B0); PG8_MMA(1, 1, At, B1); PG8_BAR; PG8_SCHED;
            } else {
            PG8_LDB(B0, 0, 0); PG8_SCHED; PG8_LDA(At, 0, 0); PG8_STAGE(PG8_SA(1, 1), a1 + hstep, voffA);
            PG8_WAIT_L(8); PG8_BAR; PG8_WAIT_L(0); PG8_MMA(0, 0, At, B0); PG8_BAR; PG8_SCHED;
            PG8_LDB(B1, 0, 1); PG8_STAGE(PG8_SB(0, 0), b2, voffB);
            PG8_BAR; PG8_WAIT_L(0); PG8_MMA(0, 1, At, B1); PG8_BAR;
            PG8_LDA(At, 0, 1); PG8_STAGE(PG8_SA(0, 0), a2, voffA);
            PG8_BAR; PG8_WAIT_L(0); PG8_MMA(1, 0, At, B0); PG8_BAR; PG8_SCHED;
            PG8_STAGE(PG8_SB(0, 1), b2 + hstep, voffB);
            PG8_WAIT_V(6); PG8_BAR; PG8_MMA(1, 1, At, B1); PG8_BAR;
            PG8_LDB(B0, 1, 0); PG8_SCHED; PG8_LDA(At, 1, 0); PG8_STAGE(PG8_SA(0, 1), a2 + hstep, voffA);
            PG8_WAIT_L(8); PG8_BAR; PG8_WAIT_L(0); PG8_MMA(0, 0, At, B0); PG8_BAR; PG8_SCHED;
            PG8_LDB(B1, 1, 1); PG8_STAGE(PG8_SB(1, 0), b3, voffB);
            PG8_BAR; PG8_WAIT_L(0); PG8_MMA(0, 1, At, B1); PG8_BAR;
            PG8_LDA(At, 1, 1); PG8_STAGE(PG8_SA(1, 0), a3, voffA);
            PG8_BAR; PG8_WAIT_L(0); PG8_MMA(1, 0, At, B0); PG8_BAR; PG8_SCHED;
            PG8_STAGE(PG8_SB(1, 1), b3 + hstep, voffB);
            PG8_WAIT_V(6); PG8_BAR; PG8_MMA(1, 1, At, B1); PG8_BAR;
            }
        }
        if constexpr (ALIGN_EPI) { if (wr == 0) PG8_BAR; }
        if constexpr (!Epi::AFTER_DRAIN) { E(acc, cur, wr, wc, fr, fq); S.done(cur); }
        if (!has_next) break;
#pragma unroll
        for (int a = 0; a < 2; ++a)
#pragma unroll
            for (int b = 0; b < 2; ++b)
#pragma unroll
                for (int m = 0; m < 4; ++m)
#pragma unroll
                    for (int n = 0; n < 2; ++n) acc[a][b][m][n] = (f32x4){0.f, 0.f, 0.f, 0.f};
        cur = nxt; cA = nA; cB = nB; ++ui;
        if constexpr (ALIGN_EPI) { if (wr == 1) PG8_BAR; }
    }
    PG8_WAIT_V(0);
    if constexpr (!ALIGN_EPI) { if (wr == 0) PG8_BAR; }
    PG8_BAR;
    if constexpr (Epi::AFTER_DRAIN) { E.fused(acc, cur, wr, wc, fr, fq, lds, wid, lane); S.done(cur); }
#undef PG8_SA
#undef PG8_SB
#undef PG8_STAGE
#undef PG8_LDA
#undef PG8_LDB
#undef PG8_MMA
#undef PG8_WAIT_V
#undef PG8_WAIT_L
#undef PG8_BAR
#undef PG8_SCHED
}
}

#define LAS __attribute__((address_space(3)))
typedef unsigned short bf16;
typedef float f32x4 __attribute__((ext_vector_type(4)));
typedef unsigned u32x4 __attribute__((ext_vector_type(4)));
typedef unsigned u32x2 __attribute__((ext_vector_type(2)));
typedef short bf16x8 __attribute__((ext_vector_type(8)));
using pg8::cvt_pk_bf16;

constexpr int NWAVES = 8, NTHR = 512;
constexpr int DM = 4096, NP = 4096, NS = 2048, MT = 6144, NKV = 7168;
constexpr int QL = 1024, KVL = 512, RD = 64, MLAW = 2048, S5W = 2048;
constexpr int INC = 15936, INP = 16128;
constexpr float LN_EPS = 1e-6f;
constexpr float ALPHA = 1.189207115002721f;

constexpr size_t MiB = 1u << 20;
constexpr size_t WS_MODP = 1 * MiB;
constexpr size_t WS_MOD = WS_MODP + 768 * 1024;
constexpr size_t WS_WIN = 2 * MiB;
constexpr size_t WS_WUQ = 128 * MiB;
constexpr size_t WS_WK = 134 * MiB;
constexpr size_t WS_WV = 136 * MiB;
constexpr size_t WS_WGLU = 138 * MiB;
constexpr size_t WS_WPAB = 146 * MiB;
constexpr size_t WS_WO = 178 * MiB;
constexpr size_t WS_H = 210 * MiB;
constexpr size_t WS_CQ = 258 * MiB;
constexpr size_t WS_CKVR = 282 * MiB;
constexpr size_t WS_KPE = 294 * MiB;
constexpr size_t WS_UB = 296 * MiB;
constexpr size_t WS_SZA = 344 * MiB;
constexpr size_t WS_SZB = 368 * MiB;
constexpr size_t WS_SGA = 392 * MiB;
constexpr size_t WS_SGB = 440 * MiB;
constexpr size_t WS_CQN = 488 * MiB;
constexpr size_t WS_CKVB = 500 * MiB;
constexpr size_t WS_KPEB = 507 * MiB;
constexpr size_t WS_Q = 508 * MiB;
constexpr size_t WS_KN = 544 * MiB;
constexpr size_t WS_VT = 572 * MiB;
constexpr size_t WS_YS5 = 600 * MiB;
constexpr size_t WS_Y5 = 696 * MiB;
constexpr size_t WS_AB = 720 * MiB;
constexpr size_t WS_MG = 768 * MiB;
constexpr size_t WS_END = 816 * MiB;

constexpr size_t O_Y = 0, O_CKV = (size_t)MT * DM, O_KPE = O_CKV + (size_t)NP * KVL, O_SRE = O_KPE + (size_t)NP * RD, O_SIM = O_SRE + 16 * 2 * 128 * 64;

constexpr int LDS_BYTES = 147456;
#ifndef PHASE_MASK
#define PHASE_MASK 0x1ff
#endif

#define LDS_WAIT() asm volatile("s_waitcnt lgkmcnt(0)" ::: "memory")
#define VM_WAIT() asm volatile("s_waitcnt vmcnt(0)" ::: "memory")

__device__ __forceinline__ unsigned f2bf(float f) { unsigned u = __builtin_bit_cast(unsigned, f); return (u + 0x7fffu + ((u >> 16) & 1u)) >> 16; }
__device__ __forceinline__ float bf2f(unsigned b) { return __builtin_bit_cast(float, b << 16); }
__device__ __forceinline__ float bflo(unsigned w) { return __builtin_bit_cast(float, w << 16); }
__device__ __forceinline__ float bfhi(unsigned w) { return __builtin_bit_cast(float, w & 0xffff0000u); }
__device__ __forceinline__ float fast_rcp(float x) { return __builtin_amdgcn_rcpf(x); }
__device__ __forceinline__ float sigmoidf_(float x) { return fast_rcp(1.0f + __expf(-x)); }
__device__ __forceinline__ float siluf_(float x) { return x * sigmoidf_(x); }
__device__ __forceinline__ float gelu_tanh(float x) {
    const float z = 0.7978845608028654f * (x + 0.044715f * x * x * x);
    const float t = 1.0f - 2.0f * fast_rcp(__expf(2.0f * z) + 1.0f);
    return 0.5f * x * (1.0f + t);
}
__device__ __forceinline__ float wave_sum(float v) {
#pragma unroll
    for (int o = 1; o < 64; o <<= 1) v += __shfl_xor(v, o);
    return v;
}
__device__ __forceinline__ void sincos_acc(float x, float& s, float& c) {
    const float k = rintf(x * 0.15915494309189535f);
    float r = fmaf(-k, 6.2831854820251465f, x);
    r = fmaf(-k, -1.7484555e-7f, r);
    float sgn = 1.0f;
    if (r > 1.5707963267948966f) { r = 3.14159274101257324f - r; r += -8.742278e-8f; sgn = -1.0f; }
    else if (r < -1.5707963267948966f) { r = -3.14159274101257324f - r; r -= -8.742278e-8f; sgn = -1.0f; }
    const float r2 = r * r;
    float ps = 1.0f / 6227020800.0f;
    ps = fmaf(ps, r2, -1.0f / 39916800.0f); ps = fmaf(ps, r2, 1.0f / 362880.0f); ps = fmaf(ps, r2, -1.0f / 5040.0f);
    ps = fmaf(ps, r2, 1.0f / 120.0f); ps = fmaf(ps, r2, -1.0f / 6.0f);
    s = fmaf(ps * r2, r, r);
    float pc = -1.0f / 87178291200.0f;
    pc = fmaf(pc, r2, 1.0f / 479001600.0f); pc = fmaf(pc, r2, -1.0f / 3628800.0f); pc = fmaf(pc, r2, 1.0f / 40320.0f);
    pc = fmaf(pc, r2, -1.0f / 720.0f); pc = fmaf(pc, r2, 1.0f / 24.0f); pc = fmaf(pc, r2, -0.5f);
    c = sgn * fmaf(pc, r2, 1.0f);
}
__device__ __forceinline__ float rope_inv(int i) { return exp2f(-(float)i * (13.287712379549449f / 16.0f)); }

__device__ __forceinline__ void p0_tile(const float* __restrict__ W, int ldw, int k0, int n0, bf16* WT, int ldk, int drow0, int koff, LAS float* scr, int lane) {
    const int n4 = lane & 15, kq = lane >> 4;
    f32x4 v[16];
#pragma unroll
    for (int i = 0; i < 16; ++i) v[i] = *(const f32x4*)(W + (size_t)(k0 + 4 * i + kq) * ldw + n0 + 4 * n4);
#pragma unroll
    for (int i = 0; i < 16; ++i) { const int kk = 4 * i + kq;
        scr[(4 * n4 + 0) * 65 + kk] = v[i].x; scr[(4 * n4 + 1) * 65 + kk] = v[i].y; scr[(4 * n4 + 2) * 65 + kk] = v[i].z; scr[(4 * n4 + 3) * 65 + kk] = v[i].w; }
    LDS_WAIT();
    const int c = lane & 7;
#pragma unroll
    for (int j = 0; j < 8; ++j) { const int n = (lane >> 3) + 8 * j; const LAS float* s = scr + n * 65 + 8 * c;
        u32x4 o; o.x = cvt_pk_bf16(s[0], s[1]); o.y = cvt_pk_bf16(s[2], s[3]); o.z = cvt_pk_bf16(s[4], s[5]); o.w = cvt_pk_bf16(s[6], s[7]);
        *(u32x4*)(WT + (size_t)(drow0 + n) * ldk + koff + k0 + 8 * c) = o; }
    LDS_WAIT();
}

struct EpiIn {
    static constexpr bool PERM = true, AFTER_DRAIN = false, HAS_MID = false;
    float* cq; float* ckvr; float* kpe; float* ub; bf16* sza; bf16* szb; bf16* sga; bf16* sgb;
    __device__ __forceinline__ void operator()(const f32x4 (&acc)[2][2][4][2], const pg8::Unit& u, int wr, int wc, int fr, int fq) const {
        const int pn = u.pn;
        int mode, ld, cb, ncol = 256; float* fp = nullptr; bf16* bp = nullptr;
        if (pn < 4) { mode = 0; fp = cq; ld = QL; cb = pn * 256; }
        else if (pn < 6) { mode = 0; fp = ckvr; ld = KVL; cb = (pn - 4) * 256; }
        else if (pn < 7) { mode = 0; fp = kpe; ld = RD; cb = 0; ncol = 64; }
        else if (pn < 15) { mode = 1; bp = sza; ld = MLAW; cb = (pn - 7) * 256; }
        else if (pn < 23) { mode = 0; fp = ub; ld = S5W; cb = (pn - 15) * 256; }
        else if (pn < 31) { mode = 1; bp = szb; ld = S5W; cb = (pn - 23) * 256; }
        else if (pn < 47) { mode = 2; bp = sga; ld = DM; cb = (pn - 31) * 256; }
        else { mode = 2; bp = sgb; ld = DM; cb = (pn - 47) * 256; }
        const int row0 = u.pm * 256 + wr * 64 + fr, c0 = wc * 32 + 8 * fq;
#pragma unroll
        for (int ai = 0; ai < 2; ++ai)
#pragma unroll
            for (int m = 0; m < 4; ++m) { const size_t row = (size_t)(row0 + ai * 128 + m * 16);
#pragma unroll
                for (int bj = 0; bj < 2; ++bj) { const int c = bj * 128 + c0; const f32x4 v0 = acc[ai][bj][m][0], v1 = acc[ai][bj][m][1];
                    if (mode == 0) { if (c < ncol) { float* p = fp + row * ld + cb + c; *(f32x4*)p = v0; *(f32x4*)(p + 4) = v1; } }
                    else { float a[8] = {v0[0], v0[1], v0[2], v0[3], v1[0], v1[1], v1[2], v1[3]};
#pragma unroll
                        for (int e = 0; e < 8; ++e) { const float sg = sigmoidf_(a[e]); a[e] = (mode == 1) ? a[e] * sg : sg; }
                        u32x4 w; w.x = cvt_pk_bf16(a[0], a[1]); w.y = cvt_pk_bf16(a[2], a[3]); w.z = cvt_pk_bf16(a[4], a[5]); w.w = cvt_pk_bf16(a[6], a[7]);
                        *(u32x4*)(bp + row * ld + cb + c) = w; } } }
    }
};
struct EpiStore {
    static constexpr bool PERM = true, AFTER_DRAIN = false, HAS_MID = false;
    bf16* O; int ldc;
    __device__ __forceinline__ void operator()(const f32x4 (&acc)[2][2][4][2], const pg8::Unit& u, int wr, int wc, int fr, int fq) const {
        const int row0 = u.pm * 256 + wr * 64 + fr, c0 = u.pn * 256 + wc * 32 + 8 * fq;
#pragma unroll
        for (int ai = 0; ai < 2; ++ai)
#pragma unroll
            for (int m = 0; m < 4; ++m) { bf16* rp = O + (size_t)(row0 + ai * 128 + m * 16) * ldc + c0;
#pragma unroll
                for (int bj = 0; bj < 2; ++bj) { const f32x4 v0 = acc[ai][bj][m][0], v1 = acc[ai][bj][m][1];
                    u32x4 w; w.x = cvt_pk_bf16(v0[0], v0[1]); w.y = cvt_pk_bf16(v0[2], v0[3]); w.z = cvt_pk_bf16(v1[0], v1[1]); w.w = cvt_pk_bf16(v1[2], v1[3]);
                    *(u32x4*)(rp + bj * 128) = w; } }
    }
};
struct EpiGlu {
    static constexpr bool PERM = true, AFTER_DRAIN = false, HAS_MID = false;
    const bf16* y5; const bf16* szb; const float* bglu; bf16* ab;
    __device__ __forceinline__ void operator()(const f32x4 (&acc)[2][2][4][2], const pg8::Unit& u, int wr, int wc, int fr, int fq) const {
        const int row0 = u.pm * 256 + wr * 64 + fr, c0 = u.pn * 256 + wc * 32 + 8 * fq;
#pragma unroll
        for (int bj = 0; bj < 2; ++bj) { const int c = c0 + bj * 128; const f32x4 b0 = *(const f32x4*)(bglu + c), b1 = *(const f32x4*)(bglu + c + 4);
#pragma unroll
            for (int ai = 0; ai < 2; ++ai)
#pragma unroll
                for (int m = 0; m < 4; ++m) { const size_t row = (size_t)(row0 + ai * 128 + m * 16);
                    const u32x4 yv = *(const u32x4*)(y5 + row * S5W + c), zv = *(const u32x4*)(szb + row * S5W + c);
                    const f32x4 v0 = acc[ai][bj][m][0] + b0, v1 = acc[ai][bj][m][1] + b1;
                    float r[8];
                    r[0] = bflo(yv.x) * sigmoidf_(v0[0]) * bflo(zv.x); r[1] = bfhi(yv.x) * sigmoidf_(v0[1]) * bfhi(zv.x);
                    r[2] = bflo(yv.y) * sigmoidf_(v0[2]) * bflo(zv.y); r[3] = bfhi(yv.y) * sigmoidf_(v0[3]) * bfhi(zv.y);
                    r[4] = bflo(yv.z) * sigmoidf_(v1[0]) * bflo(zv.z); r[5] = bfhi(yv.z) * sigmoidf_(v1[1]) * bfhi(zv.z);
                    r[6] = bflo(yv.w) * sigmoidf_(v1[2]) * bflo(zv.w); r[7] = bfhi(yv.w) * sigmoidf_(v1[3]) * bfhi(zv.w);
                    u32x4 w; w.x = cvt_pk_bf16(r[0], r[1]); w.y = cvt_pk_bf16(r[2], r[3]); w.z = cvt_pk_bf16(r[4], r[5]); w.w = cvt_pk_bf16(r[6], r[7]);
                    *(u32x4*)(ab + row * DM + MLAW + c) = w; } }
    }
};
struct EpiMerge {
    static constexpr bool PERM = true, AFTER_DRAIN = false, HAS_MID = true;
    const bf16* sga; const bf16* sgb; bf16* mg;
    __device__ __forceinline__ void mid(f32x4 (&acc)[2][2][4][2], const pg8::Unit& u, int wr, int wc, int fr, int fq) const {
        int zero_; asm volatile("v_mov_b32 %0, 0" : "=v"(zero_));
        const int row0 = u.pm * 256 + wr * 64 + fr + zero_, c0 = u.pn * 256 + wc * 32 + 8 * fq;
#pragma unroll
        for (int ai = 0; ai < 2; ++ai)
#pragma unroll
            for (int m = 0; m < 4; ++m) { const size_t row = (size_t)(row0 + ai * 128 + m * 16);
#pragma unroll
                for (int bj = 0; bj < 2; ++bj) { const int c = c0 + bj * 128;
                    const u32x4 av = *(const u32x4*)(sga + row * DM + c), bv = *(const u32x4*)(sgb + row * DM + c);
                    f32x4 r0, r1;
                    r0[0] = bflo(av.x) * fast_rcp(bflo(bv.x)); r0[1] = bfhi(av.x) * fast_rcp(bfhi(bv.x)); r0[2] = bflo(av.y) * fast_rcp(bflo(bv.y)); r0[3] = bfhi(av.y) * fast_rcp(bfhi(bv.y));
                    r1[0] = bflo(av.z) * fast_rcp(bflo(bv.z)); r1[1] = bfhi(av.z) * fast_rcp(bfhi(bv.z)); r1[2] = bflo(av.w) * fast_rcp(bflo(bv.w)); r1[3] = bfhi(av.w) * fast_rcp(bfhi(bv.w));
                    acc[ai][bj][m][0] = acc[ai][bj][m][0] * r0; acc[ai][bj][m][1] = acc[ai][bj][m][1] * r1; }
                asm volatile("" ::: "memory"); }
    }
    __device__ __forceinline__ void operator()(const f32x4 (&acc)[2][2][4][2], const pg8::Unit& u, int wr, int wc, int fr, int fq) const {
        int zero_; asm volatile("v_mov_b32 %0, 0" : "=v"(zero_));
        const int row0 = u.pm * 256 + wr * 64 + fr + zero_, c0 = u.pn * 256 + wc * 32 + 8 * fq;
#pragma unroll
        for (int ai = 0; ai < 2; ++ai)
#pragma unroll
            for (int m = 0; m < 4; ++m) { const size_t row = (size_t)(row0 + ai * 128 + m * 16);
#pragma unroll
                for (int bj = 0; bj < 2; ++bj) { const int c = c0 + bj * 128; const f32x4 v0 = acc[ai][bj][m][0], v1 = acc[ai][bj][m][1];
                    const u32x4 bv = *(const u32x4*)(sgb + row * DM + c);
                    u32x4 w; w.x = cvt_pk_bf16(v0[0] * bflo(bv.x), v0[1] * bfhi(bv.x)); w.y = cvt_pk_bf16(v0[2] * bflo(bv.y), v0[3] * bfhi(bv.y));
                    w.z = cvt_pk_bf16(v1[0] * bflo(bv.z), v1[1] * bfhi(bv.z)); w.w = cvt_pk_bf16(v1[2] * bflo(bv.w), v1[3] * bfhi(bv.w));
                    *(u32x4*)(mg + row * DM + c) = w; } }
    }
};
struct EpiOut {
    static constexpr bool PERM = true, AFTER_DRAIN = false, HAS_MID = false;
    const float* xp; const float* xs; const float* gate; float* out;
    __device__ __forceinline__ void operator()(const f32x4 (&acc)[2][2][4][2], const pg8::Unit& u, int wr, int wc, int fr, int fq) const {
        const int rt = u.pm * 256; const int cond = rt < NP ? 0 : (rt < NP + 1024 ? 1 : 2);
        const float* xb = rt < NP ? xp : xs - (size_t)NP * DM;
        const int row0 = rt + wr * 64 + fr, c0 = u.pn * 256 + wc * 32 + 8 * fq;
#pragma unroll
        for (int bj = 0; bj < 2; ++bj) { const int c = c0 + bj * 128; const f32x4 g0 = *(const f32x4*)(gate + cond * DM + c), g1 = *(const f32x4*)(gate + cond * DM + c + 4);
#pragma unroll
            for (int ai = 0; ai < 2; ++ai)
#pragma unroll
                for (int m = 0; m < 4; ++m) { const size_t off = (size_t)(row0 + ai * 128 + m * 16) * DM + c;
                    const f32x4 x0 = *(const f32x4*)(xb + off), x1 = *(const f32x4*)(xb + off + 4);
                    *(f32x4*)(out + off) = x0 * ALPHA + g0 * acc[ai][bj][m][0]; *(f32x4*)(out + off + 4) = x1 * ALPHA + g1 * acc[ai][bj][m][1]; } }
    }
};

constexpr int S5_WLDS = 10240 + 4352 + 1024;
__device__ __forceinline__ void s5_task(const float* ub, float* ys, int row0, int L, int g, int d,
                                        const float* __restrict__ a_re, const float* __restrict__ a_im, const float* __restrict__ log_dt,
                                        const float* __restrict__ b_re, const float* __restrict__ b_im, const float* __restrict__ c_re, const float* __restrict__ c_im,
                                        const float* h0re, const float* h0im, float* fre, float* fim, LAS unsigned char* wl, int lane) {
    LAS float* BuS = (LAS float*)wl; LAS unsigned char* Xs = wl + 10240; LAS float* par = (LAS float*)(wl + 10240 + 4352);
    const int fr = lane & 15, fq = lane >> 4;
    const int pg = d * 128 + g;
    float abr, abi;
    {
        const float ar = a_re[pg * 64 + lane], ai = a_im[pg * 64 + lane], dt = __expf(log_dt[pg]);
        const float mag = __expf(dt * ar); float sn, cs; sincos_acc(dt * ai, sn, cs);
        abr = mag * cs; abi = mag * sn;
        const float den = ar * ar + ai * ai, pr = abr - 1.0f;
        const float qr = (pr * ar + abi * ai) / den, qi = (abi * ar - pr * ai) / den;
        par[lane] = qr; par[64 + lane] = qi;
    }
    LDS_WAIT();
    bf16x8 Bre[4], Bim[4];
#pragma unroll
    for (int nb = 0; nb < 4; ++nb) { const int n = 16 * nb + fr; const float qr = par[n], qi = par[64 + n];
        const float* br = b_re + ((size_t)pg * 64 + n) * 16 + 8 * (fq & 1); const float* bi = b_im + ((size_t)pg * 64 + n) * 16 + 8 * (fq & 1);
        const f32x4 r0 = *(const f32x4*)br, r1 = *(const f32x4*)(br + 4), i0 = *(const f32x4*)bi, i1 = *(const f32x4*)(bi + 4);
        const f32x4 e0 = r0 * qr - i0 * qi, e1 = r1 * qr - i1 * qi, f0 = i0 * qr + r0 * qi, f1 = i1 * qr + r1 * qi;
        u32x4 wr_, wi_; wr_.x = cvt_pk_bf16(e0[0], e0[1]); wr_.y = cvt_pk_bf16(e0[2], e0[3]); wr_.z = cvt_pk_bf16(e1[0], e1[1]); wr_.w = cvt_pk_bf16(e1[2], e1[3]);
        wi_.x = cvt_pk_bf16(f0[0], f0[1]); wi_.y = cvt_pk_bf16(f0[2], f0[3]); wi_.z = cvt_pk_bf16(f1[0], f1[1]); wi_.w = cvt_pk_bf16(f1[2], f1[3]);
        Bre[nb] = __builtin_bit_cast(bf16x8, wr_); Bim[nb] = __builtin_bit_cast(bf16x8, wi_); }
    bf16x8 Cf[4];
#pragma unroll
    for (int ks = 0; ks < 4; ++ks) { const float* cp = ((ks < 2) ? c_re : c_im) + ((size_t)pg * 16 + fr) * 64 + 32 * (ks & 1) + 8 * fq; const float sg = (ks < 2) ? 1.0f : -1.0f;
        const f32x4 v0 = *(const f32x4*)cp * sg, v1 = *(const f32x4*)(cp + 4) * sg;
        u32x4 w; w.x = cvt_pk_bf16(v0[0], v0[1]); w.y = cvt_pk_bf16(v0[2], v0[3]); w.z = cvt_pk_bf16(v1[0], v1[1]); w.w = cvt_pk_bf16(v1[2], v1[3]);
        Cf[ks] = __builtin_bit_cast(bf16x8, w); }
    float xr = 0.f, xi = 0.f;
    if (h0re) { xr = h0re[lane]; xi = h0im[lane]; }
    const int nch = L >> 4;
    const float* ucol = ub + (size_t)g * 16 + 8 * (fq & 1);
    f32x4 un0, un1;
    { const int t0 = d ? (L - 16) : 0; const float* up = ucol + (size_t)(row0 + t0 + fr) * S5W; un0 = *(const f32x4*)up; un1 = *(const f32x4*)(up + 4); }
    for (int ch = 0; ch < nch; ++ch) {
        const int t0 = d ? (L - 16 - 16 * ch) : 16 * ch;
        const f32x4 u0 = un0, u1 = un1;
        if (ch + 1 < nch) { const int t1 = d ? (t0 - 16) : (t0 + 16); const float* up = ucol + (size_t)(row0 + t1 + fr) * S5W; un0 = *(const f32x4*)up; un1 = *(const f32x4*)(up + 4); }
        float uu[8] = {u0[0], u0[1], u0[2], u0[3], u1[0], u1[1], u1[2], u1[3]};
        if (fq >= 2) {
#pragma unroll
            for (int e = 0; e < 8; ++e) uu[e] = uu[e] - bf2f(f2bf(uu[e]));
        }
        u32x4 aw; aw.x = cvt_pk_bf16(uu[0], uu[1]); aw.y = cvt_pk_bf16(uu[2], uu[3]); aw.z = cvt_pk_bf16(uu[4], uu[5]); aw.w = cvt_pk_bf16(uu[6], uu[7]);
        const bf16x8 Af = __builtin_bit_cast(bf16x8, aw);
#pragma unroll
        for (int nb = 0; nb < 4; ++nb) {
            const f32x4 z = {0.f, 0.f, 0.f, 0.f};
            const f32x4 br = __builtin_amdgcn_mfma_f32_16x16x32_bf16(Af, Bre[nb], z, 0, 0, 0);
            const f32x4 bi = __builtin_amdgcn_mfma_f32_16x16x32_bf16(Af, Bim[nb], z, 0, 0, 0);
            *(LAS f32x4*)(BuS + (16 * nb + fr) * 20 + 4 * fq) = br;
            *(LAS f32x4*)(BuS + 1280 + (16 * nb + fr) * 20 + 4 * fq) = bi;
        }
        LDS_WAIT();
#pragma unroll
        for (int jj = 0; jj < 4; ++jj) { const int j = d ? (3 - jj) : jj;
            const f32x4 vr = *(const LAS f32x4*)(BuS + lane * 20 + 4 * j), vi = *(const LAS f32x4*)(BuS + 1280 + lane * 20 + 4 * j);
#pragma unroll
            for (int ii = 0; ii < 4; ++ii) { const int i = d ? (3 - ii) : ii;
                const float nr = fmaf(abr, xr, fmaf(-abi, xi, vr[i])), ni = fmaf(abr, xi, fmaf(abi, xr, vi[i]));
                xr = nr; xi = ni;
                const int t = 4 * j + i;
                *(LAS unsigned short*)(Xs + t * 272 + lane * 2) = (unsigned short)f2bf(xr);
                *(LAS unsigned short*)(Xs + t * 272 + 128 + lane * 2) = (unsigned short)f2bf(xi); } }
        LDS_WAIT();
        f32x4 y = {0.f, 0.f, 0.f, 0.f};
#pragma unroll
        for (int ks = 0; ks < 4; ++ks) { const bf16x8 xa = *(const LAS bf16x8*)(Xs + fr * 272 + (32 * ks + 8 * fq) * 2);
            y = __builtin_amdgcn_mfma_f32_16x16x32_bf16(xa, Cf[ks], y, 0, 0, 0); }
        float* yp = ys + (size_t)(row0 + t0 + 4 * fq) * S5W + g * 16 + fr;
        yp[0] = y[0]; yp[S5W] = y[1]; yp[2 * S5W] = y[2]; yp[3 * S5W] = y[3];
        LDS_WAIT();
    }
    if (fre) { fre[lane] = xr; fim[lane] = xi; }
}

constexpr int ATT_KB = 64 * 400, ATT_VB = 128 * 144, ATT_BUF = ATT_KB + ATT_VB;
__device__ __forceinline__ void attn_unit(const bf16* Q, const bf16* KN, const bf16* KPEB, const bf16* VT, const bf16* sza, bf16* ab,
                                          int qrow0, int h, int nt, int nt1, int key1, int key2, int rope_t0  ,
                                          LAS unsigned char* lds, int tid, int wave, int lane) {
    const int fr = lane & 15, fq = lane >> 4;
    bf16x8 qf[2][6];
#pragma unroll
    for (int qb = 0; qb < 2; ++qb) { const bf16* qp = Q + (size_t)(qrow0 + 32 * wave + 16 * qb + fr) * 3072 + h * 192 + 8 * fq;
#pragma unroll
        for (int ks = 0; ks < 6; ++ks) qf[qb][ks] = __builtin_bit_cast(bf16x8, *(const u32x4*)(qp + 32 * ks)); }
    if (rope_t0 >= 0) {
#pragma unroll
        for (int qb = 0; qb < 2; ++qb) { const int tq = rope_t0 + 32 * wave + 16 * qb + fr;
#pragma unroll
            for (int half = 0; half < 2; ++half) { const float pos = (float)(half == 0 ? (tq >> 6) : (tq & 63));
                u32x4 w = __builtin_bit_cast(u32x4, qf[qb][4 + half]);
                float v[8] = {bflo(w.x), bfhi(w.x), bflo(w.y), bfhi(w.y), bflo(w.z), bfhi(w.z), bflo(w.w), bfhi(w.w)};
                float o[8];
#pragma unroll
                for (int j = 0; j < 8; ++j) { const float pv = __shfl_xor(v[j], 32);
                    float sn, cs; sincos_acc(pos * rope_inv(8 * (fq & 1) + j), sn, cs);
                    o[j] = (fq < 2) ? (v[j] * cs - pv * sn) : (v[j] * cs + pv * sn); }
                w.x = cvt_pk_bf16(o[0], o[1]); w.y = cvt_pk_bf16(o[2], o[3]); w.z = cvt_pk_bf16(o[4], o[5]); w.w = cvt_pk_bf16(o[6], o[7]);
                qf[qb][4 + half] = __builtin_bit_cast(bf16x8, w); } }
    }
    f32x4 oacc[2][8];
#pragma unroll
    for (int qb = 0; qb < 2; ++qb)
#pragma unroll
        for (int db = 0; db < 8; ++db) oacc[qb][db] = (f32x4){0.f, 0.f, 0.f, 0.f};
    float mrun[2] = {-1e30f, -1e30f}, lrun[2] = {0.f, 0.f};
    const float SC = 0.07216878364870322f * 1.4426950408889634f;
    u32x4 sk0, sk1, sp, sv0, sv1;
    const int kr = tid >> 4, kc = tid & 15;
    const int pr = tid >> 3, pc = tid & 7;
    const int vr = tid >> 3, vc = tid & 7;
#define ATT_LOAD(t) do { const int key0_ = ((t) < nt1) ? key1 + 64 * (t) : key2 + 64 * ((t) - nt1); \
        sk0 = *(const u32x4*)(KN + (size_t)(key0_ + kr) * 2048 + h * 128 + 8 * kc); sk1 = *(const u32x4*)(KN + (size_t)(key0_ + kr + 32) * 2048 + h * 128 + 8 * kc); \
        sp = *(const u32x4*)(KPEB + (size_t)(key0_ + pr) * 64 + 8 * pc); \
        sv0 = *(const u32x4*)(VT + (size_t)(h * 128 + vr) * NKV + key0_ + 8 * vc); sv1 = *(const u32x4*)(VT + (size_t)(h * 128 + vr + 64) * NKV + key0_ + 8 * vc); } while (0)
#define ATT_STORE(b) do { LAS unsigned char* kb_ = lds + (b) * ATT_BUF; LAS unsigned char* vb_ = kb_ + ATT_KB; \
        *(LAS u32x4*)(kb_ + kr * 400 + kc * 16) = sk0; *(LAS u32x4*)(kb_ + (kr + 32) * 400 + kc * 16) = sk1; *(LAS u32x4*)(kb_ + pr * 400 + 256 + pc * 16) = sp; \
        *(LAS u32x4*)(vb_ + vr * 144 + vc * 16) = sv0; *(LAS u32x4*)(vb_ + (vr + 64) * 144 + vc * 16) = sv1; } while (0)
    ATT_LOAD(0); ATT_STORE(0);
    __syncthreads();
    for (int t = 0; t < nt; ++t) {
        if (t + 1 < nt) ATT_LOAD(t + 1);
        const LAS unsigned char* kb = lds + (t & 1) * ATT_BUF; const LAS unsigned char* vb = kb + ATT_KB;
        f32x4 s[2][4];
#pragma unroll
        for (int qb = 0; qb < 2; ++qb)
#pragma unroll
            for (int kb4 = 0; kb4 < 4; ++kb4) s[qb][kb4] = (f32x4){0.f, 0.f, 0.f, 0.f};
#pragma unroll
        for (int ks = 0; ks < 6; ++ks)
#pragma unroll
            for (int kb4 = 0; kb4 < 4; ++kb4) { const bf16x8 kf = *(const LAS bf16x8*)(kb + (16 * kb4 + fr) * 400 + (32 * ks + 8 * fq) * 2);
                s[0][kb4] = __builtin_amdgcn_mfma_f32_16x16x32_bf16(kf, qf[0][ks], s[0][kb4], 0, 0, 0);
                s[1][kb4] = __builtin_amdgcn_mfma_f32_16x16x32_bf16(kf, qf[1][ks], s[1][kb4], 0, 0, 0); }
        bf16x8 pf[2][2];
#pragma unroll
        for (int qb = 0; qb < 2; ++qb) {
            float mx = -1e30f;
#pragma unroll
            for (int kb4 = 0; kb4 < 4; ++kb4) { s[qb][kb4] = s[qb][kb4] * SC; mx = fmaxf(mx, fmaxf(fmaxf(s[qb][kb4][0], s[qb][kb4][1]), fmaxf(s[qb][kb4][2], s[qb][kb4][3]))); }
            mx = fmaxf(mx, __shfl_xor(mx, 16)); mx = fmaxf(mx, __shfl_xor(mx, 32));
            const float mnew = fmaxf(mrun[qb], mx), alpha = exp2f(mrun[qb] - mnew); mrun[qb] = mnew;
            float ps = 0.f;
#pragma unroll
            for (int kb4 = 0; kb4 < 4; ++kb4) {
#pragma unroll
                for (int i = 0; i < 4; ++i) { const float p = exp2f(s[qb][kb4][i] - mnew); s[qb][kb4][i] = p; ps += p; } }
            lrun[qb] = lrun[qb] * alpha + ps;
#pragma unroll
            for (int db = 0; db < 8; ++db) oacc[qb][db] = oacc[qb][db] * alpha;
#pragma unroll
            for (int kk = 0; kk < 2; ++kk) { u32x4 w; w.x = cvt_pk_bf16(s[qb][2 * kk][0], s[qb][2 * kk][1]); w.y = cvt_pk_bf16(s[qb][2 * kk][2], s[qb][2 * kk][3]);
                w.z = cvt_pk_bf16(s[qb][2 * kk + 1][0], s[qb][2 * kk + 1][1]); w.w = cvt_pk_bf16(s[qb][2 * kk + 1][2], s[qb][2 * kk + 1][3]);
                pf[qb][kk] = __builtin_bit_cast(bf16x8, w); }
        }
#pragma unroll
        for (int db = 0; db < 8; ++db)
#pragma unroll
            for (int kk = 0; kk < 2; ++kk) { const LAS unsigned char* vp = vb + (16 * db + fr) * 144 + (32 * kk + 4 * fq) * 2;
                const u32x2 lo = *(const LAS u32x2*)vp, hi = *(const LAS u32x2*)(vp + 32);
                u32x4 w; w.x = lo.x; w.y = lo.y; w.z = hi.x; w.w = hi.y; const bf16x8 vf = __builtin_bit_cast(bf16x8, w);
                oacc[0][db] = __builtin_amdgcn_mfma_f32_16x16x32_bf16(vf, pf[0][kk], oacc[0][db], 0, 0, 0);
                oacc[1][db] = __builtin_amdgcn_mfma_f32_16x16x32_bf16(vf, pf[1][kk], oacc[1][db], 0, 0, 0); }
        if (t + 1 < nt) ATT_STORE((t + 1) & 1);
        __syncthreads();
    }
#undef ATT_LOAD
#undef ATT_STORE
#pragma unroll
    for (int qb = 0; qb < 2; ++qb) { float l = lrun[qb]; l += __shfl_xor(l, 16); l += __shfl_xor(l, 32); const float inv = 1.0f / l;
        const size_t row = (size_t)(qrow0 + 32 * wave + 16 * qb + fr);
#pragma unroll
        for (int db = 0; db < 8; ++db) { const int dcol = h * 128 + 16 * db + 4 * fq; const u32x2 zv = *(const u32x2*)(sza + row * MLAW + dcol); const f32x4 o = oacc[qb][db] * inv;
            u32x2 w; w.x = cvt_pk_bf16(o[0] * bflo(zv.x), o[1] * bfhi(zv.x)); w.y = cvt_pk_bf16(o[2] * bflo(zv.y), o[3] * bfhi(zv.y));
            *(u32x2*)(ab + row * DM + dcol) = w; } }
}

struct Params { const float* in[30]; float* out; unsigned char* ws; };

__global__ void __launch_bounds__(NTHR, 2) hybrid_fwd(Params P) {
    extern __shared__ __attribute__((aligned(16))) unsigned char lds_raw[];
    LAS unsigned char* lds = (LAS unsigned char*)lds_raw;
    cg::grid_group grid = cg::this_grid();
    const int tid = threadIdx.x, lane = tid & 63, wave = __builtin_amdgcn_readfirstlane(tid >> 6);
    const int wg = blockIdx.x, G = gridDim.x;
    const int gw = wg * NWAVES + wave, NGW = G * NWAVES;
    unsigned char* ws = P.ws;
    const float* x_prompt = P.in[0]; const float* x_sample = P.in[1]; const float* cache_ckv = P.in[2]; const float* cache_kpe = P.in[3];
    const float* st_re = P.in[4]; const float* st_im = P.in[5]; const float* c_in = P.in[6]; const float* c_ctx = P.in[7];
    const float* w_ada = P.in[8]; const float* b_ada = P.in[9]; const float* w_in = P.in[10]; const float* g_qn = P.in[11]; const float* w_uq = P.in[12];
    const float* g_kvn = P.in[13]; const float* w_ukv = P.in[14];
    const float* s5_a_re = P.in[15]; const float* s5_a_im = P.in[16]; const float* s5_log_dt = P.in[17]; const float* s5_b_re = P.in[18]; const float* s5_b_im = P.in[19];
    const float* s5_c_re = P.in[20]; const float* s5_c_im = P.in[21]; const float* s5_d = P.in[22]; const float* w_glu = P.in[23]; const float* b_glu = P.in[24];
    const float* w_pa = P.in[25]; const float* w_pb = P.in[26]; const float* w_o = P.in[27]; const float* ln_g = P.in[28]; const float* ln_b = P.in[29];
    float* out = P.out;
    float* modp = (float*)(ws + WS_MODP); float* gatev = (float*)(ws + WS_MOD);
    bf16* WIN = (bf16*)(ws + WS_WIN); bf16* WUQ = (bf16*)(ws + WS_WUQ); bf16* WK = (bf16*)(ws + WS_WK); bf16* WV = (bf16*)(ws + WS_WV);
    bf16* WGLU = (bf16*)(ws + WS_WGLU); bf16* WPAB = (bf16*)(ws + WS_WPAB); bf16* WO = (bf16*)(ws + WS_WO);
    bf16* H = (bf16*)(ws + WS_H); float* CQ = (float*)(ws + WS_CQ); float* CKVR = (float*)(ws + WS_CKVR); float* KPE = (float*)(ws + WS_KPE); float* UB = (float*)(ws + WS_UB);
    bf16* SZA = (bf16*)(ws + WS_SZA); bf16* SZB = (bf16*)(ws + WS_SZB); bf16* SGA = (bf16*)(ws + WS_SGA); bf16* SGB = (bf16*)(ws + WS_SGB);
    bf16* CQN = (bf16*)(ws + WS_CQN); bf16* CKVB = (bf16*)(ws + WS_CKVB); bf16* KPEB = (bf16*)(ws + WS_KPEB);
    bf16* Q = (bf16*)(ws + WS_Q); bf16* KN = (bf16*)(ws + WS_KN); bf16* VT = (bf16*)(ws + WS_VT);
    float* YS5 = (float*)(ws + WS_YS5); bf16* Y5 = (bf16*)(ws + WS_Y5); bf16* AB = (bf16*)(ws + WS_AB); bf16* MG = (bf16*)(ws + WS_MG);

    if constexpr ((PHASE_MASK >> 0) & 1)
    {
        LAS float* scr = (LAS float*)(lds + wave * 16640);
        constexpr int I_IN = 64 * 249, I_UQ = 16 * 48, I_UKV = 8 * 64, I_GLU = 32 * 32, I_PA = 32 * 64, I_PB = 32 * 64, I_O = 64 * 64;
        constexpr int NITEMS = I_IN + I_UQ + I_UKV + I_GLU + I_PA + I_PB + I_O;
        for (int it = gw; it < NITEMS; it += NGW) {
            int r = it;
            if (r < I_IN) { const int kb = r / 249, nb = r % 249, n0 = 64 * nb; p0_tile(w_in, INC, 64 * kb, n0, WIN, DM, n0 + (n0 >= 1600 ? 192 : 0), 0, scr, lane); continue; } r -= I_IN;
            if (r < I_UQ) { const int kb = r / 48, nb = r % 48; p0_tile(w_uq, 3072, 64 * kb, 64 * nb, WUQ, QL, 64 * nb, 0, scr, lane); continue; } r -= I_UQ;
            if (r < I_UKV) { const int kb = r / 64, nb = r % 64, hh = nb >> 2, jj = nb & 3;
                p0_tile(w_ukv, 4096, 64 * kb, 64 * nb, (jj < 2) ? WK : WV, KVL, hh * 128 + (jj & 1) * 64, 0, scr, lane); continue; } r -= I_UKV;
            if (r < I_GLU) { const int kb = r / 32, nb = r % 32; p0_tile(w_glu, S5W, 64 * kb, 64 * nb, WGLU, S5W, 64 * nb, 0, scr, lane); continue; } r -= I_GLU;
            if (r < I_PA) { const int kb = r / 64, nb = r % 64; p0_tile(w_pa, DM, 64 * kb, 64 * nb, WPAB, DM, 64 * nb, 0, scr, lane); continue; } r -= I_PA;
            if (r < I_PB) { const int kb = r / 64, nb = r % 64; p0_tile(w_pb, DM, 64 * kb, 64 * nb, WPAB, DM, 64 * nb, MLAW, scr, lane); continue; } r -= I_PB;
            { const int kb = r / 64, nb = r % 64; p0_tile(w_o, DM, 64 * kb, 64 * nb, WO, DM, 64 * nb, 0, scr, lane); }
        }
        for (int i = wg * NTHR + tid; i < (1024 * KVL) / 4; i += G * NTHR) { const f32x4 v = *(const f32x4*)(cache_ckv + 4 * (size_t)i);
            u32x2 w; w.x = cvt_pk_bf16(v[0], v[1]); w.y = cvt_pk_bf16(v[2], v[3]); *(u32x2*)(CKVB + (size_t)MT * KVL + 4 * (size_t)i) = w; }
        for (int i = wg * NTHR + tid; i < (1024 * RD) / 4; i += G * NTHR) { const f32x4 v = *(const f32x4*)(cache_kpe + 4 * (size_t)i);
            u32x2 w; w.x = cvt_pk_bf16(v[0], v[1]); w.y = cvt_pk_bf16(v[2], v[3]); *(u32x2*)(KPEB + (size_t)MT * RD + 4 * (size_t)i) = w; }
        __syncthreads();
        if (wg < 240) {
            const int slab = wg % 48, kc = wg / 48, k0 = (kc * 4096) / 5, k1 = ((kc + 1) * 4096) / 5;
            f32x4 a0 = {0.f, 0.f, 0.f, 0.f}, a1 = a0, a2 = a0;
            const float* wp = w_ada + slab * 256 + 4 * lane;
#pragma unroll 4
            for (int k = k0 + wave; k < k1; k += NWAVES) {
                const f32x4 w = *(const f32x4*)(wp + (size_t)k * 12288);
                const float s0 = siluf_(c_ctx[k]), s1 = siluf_(c_in[k]), s2 = siluf_(c_in[DM + k]);
                a0 += w * s0; a1 += w * s1; a2 += w * s2;
            }
            LAS f32x4* red = (LAS f32x4*)lds;
            red[(wave * 3 + 0) * 64 + lane] = a0; red[(wave * 3 + 1) * 64 + lane] = a1; red[(wave * 3 + 2) * 64 + lane] = a2;
            __syncthreads();
            if (tid < 192) { const int cnd = tid >> 6, l = tid & 63; f32x4 s = red[cnd * 64 + l];
#pragma unroll
                for (int w = 1; w < 8; ++w) s += red[(w * 3 + cnd) * 64 + l];
                *(f32x4*)(modp + ((size_t)kc * 3 + cnd) * 12288 + slab * 256 + 4 * l) = s; }
        }
    }
    grid.sync();

    if constexpr ((PHASE_MASK >> 1) & 1)
    {
        { const int i = wg * NTHR + tid; if (i < 3 * DM) { const int cnd = i / DM, col = i % DM; float s = b_ada[2 * DM + col];
#pragma unroll
                for (int kc = 0; kc < 5; ++kc) s += modp[((size_t)kc * 3 + cnd) * 12288 + 2 * DM + col];
                gatev[i] = s; } }
        LAS float* sh = (LAS float*)lds; LAS float* sc1 = sh + DM;
        int cur_c = -1;
        for (int u = wg; u < 768; u += G) {
            const int cnd = u < 512 ? 0 : (u < 640 ? 1 : 2);
            if (cnd != cur_c) {
                __syncthreads();
                for (int col = tid; col < DM; col += NTHR) { float s = b_ada[col], t = b_ada[DM + col];
#pragma unroll
                    for (int kc = 0; kc < 5; ++kc) { s += modp[((size_t)kc * 3 + cnd) * 12288 + col]; t += modp[((size_t)kc * 3 + cnd) * 12288 + DM + col]; }
                    sh[col] = s; sc1[col] = 1.0f + t; }
                __syncthreads();
                cur_c = cnd;
            }
            const int row = 8 * u + wave;
            const float* xr = (row < NP) ? x_prompt + (size_t)row * DM : x_sample + (size_t)(row - NP) * DM;
            f32x4 v[16]; float s = 0.f;
#pragma unroll
            for (int j = 0; j < 16; ++j) { v[j] = *(const f32x4*)(xr + 4 * lane + 256 * j); s += (v[j][0] + v[j][1]) + (v[j][2] + v[j][3]); }
            const float mean = wave_sum(s) * (1.0f / DM); float s2 = 0.f;
#pragma unroll
            for (int j = 0; j < 16; ++j) { v[j] = v[j] - mean; s2 += (v[j][0] * v[j][0] + v[j][1] * v[j][1]) + (v[j][2] * v[j][2] + v[j][3] * v[j][3]); }
            const float rstd = 1.0f / sqrtf(wave_sum(s2) * (1.0f / DM) + LN_EPS);
            bf16* hr = H + (size_t)row * DM;
#pragma unroll
            for (int j = 0; j < 16; ++j) { const int col = 4 * lane + 256 * j; const f32x4 a = *(const LAS f32x4*)(sc1 + col), b = *(const LAS f32x4*)(sh + col);
                const f32x4 o = v[j] * rstd * a + b; u32x2 w; w.x = cvt_pk_bf16(o[0], o[1]); w.y = cvt_pk_bf16(o[2], o[3]); *(u32x2*)(hr + col) = w; }
        }
    }
    grid.sync();

    if constexpr ((PHASE_MASK >> 2) & 1)
    {
        pg8::Gemm g{H, WIN, MT, INP, DM}; pg8::StaticOrder S; S.init(MT, INP, G, wg);
        EpiIn E{CQ, CKVR, KPE, UB, SZA, SZB, SGA, SGB};
        pg8::gemm_phase<EpiIn, pg8::StaticOrder, true, true>(lds, g, S, E);
    }
    grid.sync();

    if constexpr ((PHASE_MASK >> 3) & 1)
    {
        for (int row = gw; row < MT; row += NGW) {
            {
                f32x4 v[4]; float s = 0.f;
#pragma unroll
                for (int j = 0; j < 4; ++j) { v[j] = *(const f32x4*)(CQ + (size_t)row * QL + 4 * lane + 256 * j); s += (v[j][0] * v[j][0] + v[j][1] * v[j][1]) + (v[j][2] * v[j][2] + v[j][3] * v[j][3]); }
                const float rs = 1.0f / sqrtf(wave_sum(s) * (1.0f / QL) + LN_EPS);
#pragma unroll
                for (int j = 0; j < 4; ++j) { const int col = 4 * lane + 256 * j; const f32x4 gq = *(const f32x4*)(g_qn + col); const f32x4 o = v[j] * rs * gq;
                    u32x2 w; w.x = cvt_pk_bf16(o[0], o[1]); w.y = cvt_pk_bf16(o[2], o[3]); *(u32x2*)(CQN + (size_t)row * QL + col) = w; }
            }
            {
                f32x4 v[2]; float s = 0.f;
#pragma unroll
                for (int j = 0; j < 2; ++j) { v[j] = *(const f32x4*)(CKVR + (size_t)row * KVL + 4 * lane + 256 * j); s += (v[j][0] * v[j][0] + v[j][1] * v[j][1]) + (v[j][2] * v[j][2] + v[j][3] * v[j][3]); }
                const float rs = 1.0f / sqrtf(wave_sum(s) * (1.0f / KVL) + LN_EPS);
#pragma unroll
                for (int j = 0; j < 2; ++j) { const int col = 4 * lane + 256 * j; const f32x4 gk = *(const f32x4*)(g_kvn + col); const f32x4 o = v[j] * rs * gk;
                    u32x2 w; w.x = cvt_pk_bf16(o[0], o[1]); w.y = cvt_pk_bf16(o[2], o[3]); *(u32x2*)(CKVB + (size_t)row * KVL + col) = w;
                    if (row < NP) *(f32x4*)(out + O_CKV + (size_t)row * KVL + col) = o; }
            }
            {
                const float kv = KPE[(size_t)row * RD + lane]; float o = kv;
                if (row < NP) out[O_KPE + (size_t)row * RD + lane] = kv;
                else { const int t = (row - NP) & 1023; const float pos = (float)((lane < 32) ? (t >> 6) : (t & 63)); const float pv = __shfl_xor(kv, 16);
                    float sn, cs; sincos_acc(pos * rope_inv(lane & 15), sn, cs);
                    o = ((lane & 16) == 0) ? (kv * cs - pv * sn) : (kv * cs + pv * sn); }
                KPEB[(size_t)row * RD + lane] = (bf16)f2bf(o);
            }
        }
        LAS unsigned char* wl = lds + wave * S5_WLDS;
        if (wave < 2) {
            const int id = wg * 2 + wave;
            if (id < 512) { const int b = id >> 8, g = (id & 255) >> 1, d = id & 1;
                s5_task(UB, YS5 + (size_t)d * MT * S5W, NP + b * 1024, 1024, g, d, s5_a_re, s5_a_im, s5_log_dt, s5_b_re, s5_b_im, s5_c_re, s5_c_im,
                        st_re + ((size_t)(b * 2 + d) * 128 + g) * 64, st_im + ((size_t)(b * 2 + d) * 128 + g) * 64, nullptr, nullptr, wl, lane); }
        } else {
            for (int j = 0; j < 3; ++j) { const int pid = wg * 6 + (wave - 2) + 1536 * j;
                if (pid < 4096) { const int d = pid & 1, pgi = pid >> 1, b = pgi >> 7, g = pgi & 127;
                    s5_task(UB, YS5 + (size_t)d * MT * S5W, b * 256, 256, g, d, s5_a_re, s5_a_im, s5_log_dt, s5_b_re, s5_b_im, s5_c_re, s5_c_im,
                            nullptr, nullptr, out + O_SRE + ((size_t)(b * 2 + d) * 128 + g) * 64, out + O_SIM + ((size_t)(b * 2 + d) * 128 + g) * 64, wl, lane); } }
        }
        VM_WAIT();
        __syncthreads();
        for (int pi = 0; pi < 10; ++pi) {
            int row0, L, g;
            if (pi == 0) { if (wg >= 256) continue; row0 = NP + (wg >> 7) * 1024; L = 1024; g = wg & 127; }
            else { const int pp = (pi - 1) % 3, j = (pi - 1) / 3; const int pgi = wg * 3 + pp + 768 * j; if (pgi >= 2048) continue; row0 = (pgi >> 7) * 256; L = 256; g = pgi & 127; }
            for (int it = tid; it < L * 4; it += NTHR) { const int t = it >> 2, q4 = it & 3; const size_t off = (size_t)(row0 + t) * S5W + g * 16 + 4 * q4;
                const f32x4 u = *(const f32x4*)(UB + off), y0 = *(const f32x4*)(YS5 + off), y1 = *(const f32x4*)(YS5 + (size_t)MT * S5W + off), dk = *(const f32x4*)(s5_d + g * 16 + 4 * q4);
                const f32x4 y = dk * u + y0 + y1;
                u32x2 w; w.x = cvt_pk_bf16(gelu_tanh(y[0]), gelu_tanh(y[1])); w.y = cvt_pk_bf16(gelu_tanh(y[2]), gelu_tanh(y[3])); *(u32x2*)(Y5 + off) = w; }
        }
    }
    grid.sync();

    if constexpr ((PHASE_MASK >> 4) & 1)
    {
        { pg8::Gemm g{Y5, WGLU, MT, S5W, S5W}; pg8::StaticOrder S; S.init(MT, S5W, G, wg); EpiGlu E{Y5, SZB, b_glu, AB};
          pg8::gemm_phase<EpiGlu, pg8::StaticOrder, true, true>(lds, g, S, E); }
        __syncthreads();
        { pg8::Gemm g{CQN, WUQ, MT, 3072, QL}; pg8::StaticOrder S; S.init(MT, 3072, G, (wg + 64) % G); EpiStore E{Q, 3072};
          pg8::gemm_phase<EpiStore, pg8::StaticOrder, true, true>(lds, g, S, E); }
        __syncthreads();
        { pg8::Gemm g{CKVB, WK, NKV, 2048, KVL}; pg8::StaticOrder S; S.init(NKV, 2048, G, (wg + 32) % G); EpiStore E{KN, 2048};
          pg8::gemm_phase<EpiStore, pg8::StaticOrder, true, true>(lds, g, S, E); }
        __syncthreads();
        { pg8::Gemm g{WV, CKVB, 2048, NKV, KVL}; pg8::StaticOrder S; S.init(2048, NKV, G, wg); EpiStore E{VT, NKV};
          pg8::gemm_phase<EpiStore, pg8::StaticOrder, true, true>(lds, g, S, E); }
    }
    grid.sync();

    if constexpr ((PHASE_MASK >> 5) & 1)
    {
        for (int rnd = 0; rnd < 2; ++rnd) {
            int qrow0, h, nt, nt1, key1, key2, rope_t0;
            if (wg < 128) { if (rnd) break; const int b = wg >> 6, hq = wg & 63; h = hq >> 2; const int qb = hq & 3;
                qrow0 = NP + b * 1024 + qb * 256; nt = 24; nt1 = 16; key1 = NP + b * 1024; key2 = MT + b * 512; rope_t0 = qb * 256; }
            else { const int uid = (wg - 128) * 2 + rnd; if (uid >= 256) break; const int b = uid >> 4; h = uid & 15;
                qrow0 = b * 256; nt = 4; nt1 = 4; key1 = b * 256; key2 = 0; rope_t0 = -1; }
            attn_unit(Q, KN, KPEB, VT, SZA, AB, qrow0, h, nt, nt1, key1, key2, rope_t0, lds, tid, wave, lane);
            __syncthreads();
        }
    }
    grid.sync();

    if constexpr ((PHASE_MASK >> 6) & 1)
    {
        pg8::Gemm g{AB, WPAB, MT, DM, DM}; pg8::StaticOrder S; S.init(MT, DM, G, wg); EpiMerge E{SGA, SGB, MG};
        pg8::gemm_phase<EpiMerge, pg8::StaticOrder, true, true>(lds, g, S, E);
    }
    grid.sync();

    if constexpr ((PHASE_MASK >> 7) & 1)
    {
        pg8::Gemm g{MG, WO, MT, DM, DM}; pg8::StaticOrder S; S.init(MT, DM, G, (wg + 128) % G); EpiOut E{x_prompt, x_sample, gatev, out};
        pg8::gemm_phase<EpiOut, pg8::StaticOrder, true, true>(lds, g, S, E);
    }
    grid.sync();

    if constexpr ((PHASE_MASK >> 8) & 1)
    for (int row = gw; row < MT; row += NGW) {
        float* zr = out + (size_t)row * DM;
        f32x4 v[16]; float s = 0.f;
#pragma unroll
        for (int j = 0; j < 16; ++j) { v[j] = *(const f32x4*)(zr + 4 * lane + 256 * j); s += (v[j][0] + v[j][1]) + (v[j][2] + v[j][3]); }
        const float mean = wave_sum(s) * (1.0f / DM); float s2 = 0.f;
#pragma unroll
        for (int j = 0; j < 16; ++j) { v[j] = v[j] - mean; s2 += (v[j][0] * v[j][0] + v[j][1] * v[j][1]) + (v[j][2] * v[j][2] + v[j][3] * v[j][3]); }
        const float rstd = 1.0f / sqrtf(wave_sum(s2) * (1.0f / DM) + LN_EPS);
#pragma unroll
        for (int j = 0; j < 16; ++j) { const int col = 4 * lane + 256 * j; const f32x4 gg = *(const f32x4*)(ln_g + col), bb = *(const f32x4*)(ln_b + col);
            *(f32x4*)(zr + col) = v[j] * rstd * gg + bb; }
    }
}

extern "C" void kernel_launch(void* const* d_in, const int* in_sizes, int n_in, void* d_out, int out_size, void* d_ws, size_t ws_size, hipStream_t stream) {
    static int grid = 0;
    if (grid == 0) {
        if (n_in != 30 || ws_size < WS_END) { fprintf(stderr, "kernel_launch: need 30 inputs and %zu bytes of workspace; got %d, %zu\n", (size_t)WS_END, n_in, ws_size); grid = -1; return; }
        int dev = 0, cus = 0, per_cu = 0;
        hipGetDevice(&dev); hipDeviceGetAttribute(&cus, hipDeviceAttributeMultiprocessorCount, dev);
        if (hipFuncSetAttribute((const void*)hybrid_fwd, hipFuncAttributeMaxDynamicSharedMemorySize, LDS_BYTES) != hipSuccess) { fprintf(stderr, "kernel_launch: hipFuncSetAttribute failed\n"); grid = -1; return; }
        hipOccupancyMaxActiveBlocksPerMultiprocessor(&per_cu, (const void*)hybrid_fwd, NTHR, LDS_BYTES);
        (void)hipGetLastError();
        if (per_cu < 1) { fprintf(stderr, "kernel_launch: occupancy query says %d blocks per CU\n", per_cu); per_cu = 1; }
        grid = cus;
    }
    if (grid < 0) return;
    Params p{};
    for (int i = 0; i < 30; ++i) p.in[i] = (const float*)d_in[i];
    p.out = (float*)d_out; p.ws = (unsigned char*)d_ws;
    void* args[] = {&p};
    hipError_t e = hipLaunchCooperativeKernel((const void*)hybrid_fwd, dim3(grid), dim3(NTHR), args, LDS_BYTES, stream);
    if (e != hipSuccess) fprintf(stderr, "cooperative launch failed: %s (grid %d)\n", hipGetErrorString(e), grid);
}
```

```cpp
#include <hip/hip_runtime.h>
#include <hip/hip_cooperative_groups.h>
#include <cstdio>
#include <cstdint>
namespace cg = cooperative_groups;
namespace pg8 {
#define PG8_LAS __attribute__((address_space(3)))
typedef unsigned short bf16_t;
typedef short bf16x8 __attribute__((ext_vector_type(8)));
typedef float f32x4 __attribute__((ext_vector_type(4)));
typedef unsigned u32x4 __attribute__((ext_vector_type(4)));
constexpr int BM = 256, BK = 64, HALF = 128, HTB = HALF * BK * 2  , STAGE_BYTES = 8 * HTB, NXCD = 8, WGM = 8;

__host__ __device__ __forceinline__ int lds_byte(int r, int c) { const int st = (r >> 4) * 2 + (c >> 5), rr = r & 15, cc = c & 31, ob = rr * 64 + cc * 2; return st * 1024 + (ob ^ (((ob >> 9) & 1) << 5)); }
__host__ __device__ __forceinline__ void stage_rc(int b, int& R, int& C) { const int st = b / 1024, sb = b % 1024, swz = sb ^ (((sb >> 9) & 1) << 5); R = (st >> 1) * 16 + swz / 64; C = (st & 1) * 32 + (swz % 64) / 2; }
__host__ __device__ __forceinline__ int perm32(int rho) { const int n = rho >> 4, i = rho & 15; return 8 * (i >> 2) + 4 * n + (i & 3); }

struct Unit { int pm, pn; };
struct Gemm { const bf16_t* A; const bf16_t* Bt; int M, N, K; };

struct StaticOrder {
    int nM, nN, nwg, G, c;
    __host__ __device__ void init(int M, int N, int G_, int c_) { nM = M / BM; nN = N / BM; nwg = nM * nN; G = G_; c = c_; }
    __host__ __device__ bool next(int i, Unit& u) const {
        const long L = (long)i * G + c; if (L >= nwg) return false;
        int wgid = (int)L; { const int q = nwg / NXCD, r = nwg % NXCD, xcd = wgid % NXCD, off = wgid / NXCD; wgid = (xcd < r ? xcd * (q + 1) : r * (q + 1) + (xcd - r) * q) + off; }
        const int nig = WGM * nN, gid = wgid / nig, fm = gid * WGM, gsz = (nM - fm) < WGM ? (nM - fm) : WGM;
        u.pm = fm + ((wgid % nig) % gsz); u.pn = (wgid % nig) / gsz; return true;
    }
    __device__ __forceinline__ void a_ready(const Unit&) const {}
    __device__ __forceinline__ void done(const Unit&) const {}
};

__device__ __forceinline__ unsigned cvt_pk_bf16(float lo, float hi) { unsigned r; asm volatile("v_cvt_pk_bf16_f32 %0, %1, %2" : "=v"(r) : "v"(lo), "v"(hi)); return r; }
typedef float f32x2 __attribute__((ext_vector_type(2)));
template <class Epi, class Sched, bool ALIGN_EPI = false, bool SP2 = false>
__device__ __forceinline__ void gemm_phase(PG8_LAS unsigned char* lds, const Gemm g, const Sched& S, const Epi& E) {
    const int tid = threadIdx.x, wid = __builtin_amdgcn_readfirstlane(tid >> 6), lane = tid & 63, wr = wid >> 2, wc = wid & 3, fr = lane & 15, fq = lane >> 4;
    const int K = g.K, nt = K / BK;
    unsigned voffA[2], voffB[2];
#pragma unroll
    for (int i = 0; i < 2; ++i) { int R, C; stage_rc(tid * 16 + i * 8192, R, C); const int Rb = Epi::PERM ? ((R & ~31) + perm32(R & 31)) : R;
        voffA[i] = (unsigned)(R * K + C) * 2u; voffB[i] = (unsigned)(Rb * K + C) * 2u; }
    const size_t kstep = (size_t)(BK * 2);
    const size_t hstep = (size_t)HALF * K * 2;
    const size_t tstep = 2 * hstep;
    const unsigned ldsw = (unsigned)wid * 1024u;
    const int aoff = lds_byte(wr * 64 + fr, fq * 8), boff = lds_byte(wc * 32 + fr, fq * 8);
#define PG8_SA(b, h) (((b) * 2 + (h)) * HTB)
#define PG8_SB(b, h) ((4 + (b) * 2 + (h)) * HTB)
#define PG8_STAGE(bufoff, gbase, voff) do { _Pragma("unroll") for (int _i = 0; _i < 2; ++_i) \
        __builtin_amdgcn_global_load_lds((const unsigned*)((const char*)(gbase) + (voff)[_i]), (PG8_LAS unsigned*)(lds + (bufoff) + ldsw + _i * 8192), 16, 0, 0); } while (0)
#define PG8_LDA(dst, b, h) do { _Pragma("unroll") for (int m = 0; m < 4; ++m) _Pragma("unroll") for (int k = 0; k < 2; ++k) dst[m][k] = *(const PG8_LAS bf16x8*)(lds + PG8_SA(b, h) + aoff + m * 2048 + k * 1024); } while (0)
#define PG8_LDB(dst, b, h) do { _Pragma("unroll") for (int n = 0; n < 2; ++n) _Pragma("unroll") for (int k = 0; k < 2; ++k) dst[n][k] = *(const PG8_LAS bf16x8*)(lds + PG8_SB(b, h) + boff + n * 2048 + k * 1024); } while (0)
#define PG8_MMA(ai, bj, At, Bt) do { __builtin_amdgcn_s_setprio(1); _Pragma("unroll") for (int m = 0; m < 4; ++m) _Pragma("unroll") for (int n = 0; n < 2; ++n) _Pragma("unroll") for (int k = 0; k < 2; ++k) \
        acc[ai][bj][m][n] = __builtin_amdgcn_mfma_f32_16x16x32_bf16(Bt[n][k], At[m][k], acc[ai][bj][m][n], 0, 0, 0); __builtin_amdgcn_s_setprio(0); } while (0)
#define PG8_WAIT_V(n) asm volatile("s_waitcnt vmcnt(" #n ")" ::: "memory")
#define PG8_WAIT_L(n) asm volatile("s_waitcnt lgkmcnt(" #n ")" ::: "memory")
#define PG8_BAR __builtin_amdgcn_s_barrier()
#define PG8_SCHED __builtin_amdgcn_sched_barrier(0)
    Unit cur, nxt; int ui = 0;
    if (!S.next(0, cur)) return;
    f32x4 acc[2][2][4][2];
#pragma unroll
    for (int a = 0; a < 2; ++a)
#pragma unroll
        for (int b = 0; b < 2; ++b)
#pragma unroll
            for (int m = 0; m < 4; ++m)
#pragma unroll
                for (int n = 0; n < 2; ++n) acc[a][b][m][n] = (f32x4){0.f, 0.f, 0.f, 0.f};
    bf16x8 At[4][2], B0[2][2], B1[2][2];
    const char* cA = (const char*)g.A + (size_t)cur.pm * tstep; const char* cB = (const char*)g.Bt + (size_t)cur.pn * tstep;
    S.a_ready(cur);
    if constexpr (SP2) {
        PG8_STAGE(PG8_SB(0, 0), cB, voffB); PG8_STAGE(PG8_SB(0, 1), cB + hstep, voffB); PG8_STAGE(PG8_SA(0, 0), cA, voffA); PG8_STAGE(PG8_SA(0, 1), cA + hstep, voffA);
        if (wr == 1) PG8_BAR;
        PG8_WAIT_V(2); PG8_BAR;
        PG8_STAGE(PG8_SB(1, 0), cB + kstep, voffB); PG8_STAGE(PG8_SA(1, 0), cA + kstep, voffA); PG8_STAGE(PG8_SB(1, 1), cB + hstep + kstep, voffB);
        PG8_WAIT_V(6); PG8_BAR;
    } else {
        PG8_STAGE(PG8_SB(0, 0), cB, voffB); PG8_STAGE(PG8_SA(0, 0), cA, voffA); PG8_STAGE(PG8_SB(0, 1), cB + hstep, voffB); PG8_STAGE(PG8_SA(0, 1), cA + hstep, voffA);
        if (wr == 1) PG8_BAR;
        PG8_WAIT_V(4); PG8_BAR;
        PG8_STAGE(PG8_SB(1, 0), cB + kstep, voffB); PG8_STAGE(PG8_SA(1, 0), cA + kstep, voffA); PG8_STAGE(PG8_SB(1, 1), cB + hstep + kstep, voffB);
        PG8_WAIT_V(6); PG8_BAR;
    }
    for (;;) {
        const bool has_next = S.next(ui + 1, nxt);
        const char* nA = has_next ? (const char*)g.A + (size_t)nxt.pm * tstep : cA; const char* nB = has_next ? (const char*)g.Bt + (size_t)nxt.pn * tstep : cB;
        for (int t = 0; t < nt; t += 2) {
            const bool last = (t == nt - 2);
            if constexpr (Epi::HAS_MID) { if (t == (nt >> 1)) E.mid(acc, cur, wr, wc, fr, fq); }
            const char* a1 = cA + (size_t)(t + 1) * kstep;
            const char* a2 = last ? nA : cA + (size_t)(t + 2) * kstep; const char* b2 = last ? nB : cB + (size_t)(t + 2) * kstep;
            const char* a3 = a2 + kstep; const char* b3 = b2 + kstep;
            if (last && has_next) S.a_ready(nxt);
            if constexpr (SP2) {
            PG8_LDB(B0, 0, 0); PG8_LDB(B1, 0, 1); PG8_SCHED; PG8_LDA(At, 0, 0); PG8_STAGE(PG8_SA(1, 1), a1 + hstep, voffA);
            PG8_WAIT_V(8); PG8_WAIT_L(0); PG8_BAR; PG8_MMA(0, 0, At, B0); PG8_MMA(0, 1, At, B1); PG8_BAR; PG8_SCHED;
            PG8_LDA(At, 0, 1); PG8_STAGE(PG8_SB(0, 0), b2, voffB); PG8_STAGE(PG8_SB(0, 1), b2 + hstep, voffB); PG8_STAGE(PG8_SA(0, 0), a2, voffA);
            PG8_WAIT_V(8); PG8_WAIT_L(0); PG8_BAR; PG8_MMA(1, 0, At, B0); PG8_MMA(1, 1, At, B1); PG8_BAR; PG8_SCHED;
            PG8_LDB(B0, 1, 0); PG8_LDB(B1, 1, 1); PG8_SCHED; PG8_LDA(At, 1, 0); PG8_STAGE(PG8_SA(0, 1), a2 + hstep, voffA);
            PG8_WAIT_V(8); PG8_WAIT_L(0); PG8_BAR; PG8_MMA(0, 0, At, B0); PG8_MMA(0, 1, At, B1); PG8_BAR; PG8_SCHED;
            PG8_LDA(At, 1, 1); PG8_STAGE(PG8_SB(1, 0), b3, voffB); PG8_STAGE(PG8_SB(1, 1), b3 + hstep, voffB); PG8_STAGE(PG8_SA(1, 0), a3, voffA);
            PG8_WAIT_V(8); PG8_WAIT_L(0); PG8_BAR; PG8_MMA(1, 0, At, B0); PG8_MMA(1, 1, At, B1); PG8_BAR; PG8_SCHED;
            } else {
            PG8_LDB(B0, 0, 0); PG8_SCHED; PG8_LDA(At, 0, 0); PG8_STAGE(PG8_SA(1, 1), a1 + hstep, voffA);
            PG8_WAIT_L(8); PG8_BAR; PG8_WAIT_L(0); PG8_MMA(0, 0, At, B0); PG8_BAR; PG8_SCHED;
            PG8_LDB(B1, 0, 1); PG8_STAGE(PG8_SB(0, 0), b2, voffB);
            PG8_BAR; PG8_WAIT_L(0); PG8_MMA(0, 1, At, B1); PG8_BAR;
            PG8_LDA(At, 0, 1); PG8_STAGE(PG8_SA(0, 0), a2, voffA);
            PG8_BAR; PG8_WAIT_L(0); PG8_MMA(1, 0, At, B0); PG8_BAR; PG8_SCHED;
            PG8_STAGE(PG8_SB(0, 1), b2 + hstep, voffB);
            PG8_WAIT_V(6); PG8_BAR; PG8_MMA(1, 1, At, B1); PG8_BAR;
            PG8_LDB(B0, 1, 0); PG8_SCHED; PG8_LDA(At, 1, 0); PG8_STAGE(PG8_SA(0, 1), a2 + hstep, voffA);
            PG8_WAIT_L(8); PG8_BAR; PG8_WAIT_L(0); PG8_MMA(0, 0, At, B0); PG8_BAR; PG8_SCHED;
            PG8_LDB(B1, 1, 1); PG8_STAGE(PG8_SB(1, 0), b3, voffB);
            PG8_BAR; PG8_WAIT_L(0); PG8_MMA(0, 1, At, B1); PG8_BAR;
            PG8_LDA(At, 1, 1); PG8_STAGE(PG8_SA(1, 0), a3, voffA);
            PG8_BAR; PG8_WAIT_L(0); PG8_MMA(1, 0, At, B0); PG8_BAR; PG8_SCHED;
            PG8_STAGE(PG8_SB(1, 1), b3 + hstep, voffB);
            PG8_WAIT_V(6); PG8_BAR; PG8_MMA(1, 1, At, B1); PG8_BAR;
            }
        }
        if constexpr (ALIGN_EPI) { if (wr == 0) PG8_BAR; }
        if constexpr (!Epi::AFTER_DRAIN) { E(acc, cur, wr, wc, fr, fq); S.done(cur); }
        if (!has_next) break;
#pragma unroll
        for (int a = 0; a < 2; ++a)
#pragma unroll
            for (int b = 0; b < 2; ++b)
#pragma unroll
                for (int m = 0; m < 4; ++m)
#pragma unroll
                    for (int n = 0; n < 2; ++n) acc[a][b][m][n] = (f32x4){0.f, 0.f, 0.f, 0.f};
        cur = nxt; cA = nA; cB = nB; ++ui;
        if constexpr (ALIGN_EPI) { if (wr == 1) PG8_BAR; }
    }
    PG8_WAIT_V(0);
    if constexpr (!ALIGN_EPI) { if (wr == 0) PG8_BAR; }
    PG8_BAR;
    if constexpr (Epi::AFTER_DRAIN) { E.fused(acc, cur, wr, wc, fr, fq, lds, wid, lane); S.done(cur); }
#undef PG8_SA
#undef PG8_SB
#undef PG8_STAGE
#undef PG8_LDA
#undef PG8_LDB
#undef PG8_MMA
#undef PG8_WAIT_V
#undef PG8_WAIT_L
#undef PG8_BAR
#undef PG8_SCHED
}
}

#define LAS __attribute__((address_space(3)))
typedef unsigned short bf16;
typedef float f32x4 __attribute__((ext_vector_type(4)));
typedef unsigned u32x4 __attribute__((ext_vector_type(4)));
typedef unsigned u32x2 __attribute__((ext_vector_type(2)));
typedef short bf16x8 __attribute__((ext_vector_type(8)));
using pg8::cvt_pk_bf16;

constexpr int NWAVES = 8, NTHR = 512;
constexpr int DM = 4096, NP = 4096, NS = 2048, MT = 6144, NKV = 7168;
constexpr int QL = 1024, KVL = 512, RD = 64, MLAW = 2048, S5W = 2048;
constexpr int INC = 15936, INP = 16128;
constexpr float LN_EPS = 1e-6f;
constexpr float ALPHA = 1.189207115002721f;

constexpr size_t MiB = 1u << 20;
constexpr size_t WS_CTL = 0, CTL_ZERO_BYTES = 64 * 1024;
constexpr size_t WS_MODP = 1 * MiB;
constexpr size_t WS_MOD = WS_MODP + 768 * 1024;
constexpr size_t WS_WIN = 2 * MiB;
constexpr size_t WS_WUQ = 128 * MiB;
constexpr size_t WS_WK = 134 * MiB;
constexpr size_t WS_WV = 136 * MiB;
constexpr size_t WS_WGLU = 138 * MiB;
constexpr size_t WS_WPAB = 146 * MiB;
constexpr size_t WS_WO = 178 * MiB;
constexpr size_t WS_H = 210 * MiB;
constexpr size_t WS_CQ = 258 * MiB;
constexpr size_t WS_CKVR = 282 * MiB;
constexpr size_t WS_KPE = 294 * MiB;
constexpr size_t WS_UB = 296 * MiB;
constexpr size_t WS_SZA = 344 * MiB;
constexpr size_t WS_SZB = 368 * MiB;
constexpr size_t WS_SGA = 392 * MiB;
constexpr size_t WS_SGB = 440 * MiB;
constexpr size_t WS_CQN = 488 * MiB;
constexpr size_t WS_CKVB = 500 * MiB;
constexpr size_t WS_KPEB = 507 * MiB;
constexpr size_t WS_Q = 508 * MiB;
constexpr size_t WS_KN = 544 * MiB;
constexpr size_t WS_VT = 572 * MiB;
constexpr size_t WS_YS5 = 600 * MiB;
constexpr size_t WS_Y5 = 696 * MiB;
constexpr size_t WS_AB = 720 * MiB;
constexpr size_t WS_MG = 768 * MiB;
constexpr size_t WS_END = 816 * MiB;

constexpr size_t O_Y = 0, O_CKV = (size_t)MT * DM, O_KPE = O_CKV + (size_t)NP * KVL, O_SRE = O_KPE + (size_t)NP * RD, O_SIM = O_SRE + 16 * 2 * 128 * 64;

constexpr int LDS_BYTES = 147456;
#ifndef PHASE_MASK
#define PHASE_MASK 0x1ff
#endif

#define LDS_WAIT() asm volatile("s_waitcnt lgkmcnt(0)" ::: "memory")
#define VM_WAIT() asm volatile("s_waitcnt vmcnt(0)" ::: "memory")

__device__ __forceinline__ unsigned f2bf(float f) { unsigned u = __builtin_bit_cast(unsigned, f); return (u + 0x7fffu + ((u >> 16) & 1u)) >> 16; }
__device__ __forceinline__ float bf2f(unsigned b) { return __builtin_bit_cast(float, b << 16); }
__device__ __forceinline__ float bflo(unsigned w) { return __builtin_bit_cast(float, w << 16); }
__device__ __forceinline__ float bfhi(unsigned w) { return __builtin_bit_cast(float, w & 0xffff0000u); }
__device__ __forceinline__ float fast_rcp(float x) { return __builtin_amdgcn_rcpf(x); }
__device__ __forceinline__ float sigmoidf_(float x) { return fast_rcp(1.0f + __expf(-x)); }
__device__ __forceinline__ float siluf_(float x) { return x * sigmoidf_(x); }
__device__ __forceinline__ float gelu_tanh(float x) {
    const float z = 0.7978845608028654f * (x + 0.044715f * x * x * x);
    const float t = 1.0f - 2.0f * fast_rcp(__expf(2.0f * z) + 1.0f);
    return 0.5f * x * (1.0f + t);
}
__device__ __forceinline__ float wave_sum(float v) {
#pragma unroll
    for (int o = 1; o < 64; o <<= 1) v += __shfl_xor(v, o);
    return v;
}
__device__ __forceinline__ void sincos_acc(float x, float& s, float& c) {
    const float k = rintf(x * 0.15915494309189535f);
    float r = fmaf(-k, 6.2831854820251465f, x);
    r = fmaf(-k, -1.7484555e-7f, r);
    float sgn = 1.0f;
    if (r > 1.5707963267948966f) { r = 3.14159274101257324f - r; r += -8.742278e-8f; sgn = -1.0f; }
    else if (r < -1.5707963267948966f) { r = -3.14159274101257324f - r; r -= -8.742278e-8f; sgn = -1.0f; }
    const float r2 = r * r;
    float ps = 1.0f / 6227020800.0f;
    ps = fmaf(ps, r2, -1.0f / 39916800.0f); ps = fmaf(ps, r2, 1.0f / 362880.0f); ps = fmaf(ps, r2, -1.0f / 5040.0f);
    ps = fmaf(ps, r2, 1.0f / 120.0f); ps = fmaf(ps, r2, -1.0f / 6.0f);
    s = fmaf(ps * r2, r, r);
    float pc = -1.0f / 87178291200.0f;
    pc = fmaf(pc, r2, 1.0f / 479001600.0f); pc = fmaf(pc, r2, -1.0f / 3628800.0f); pc = fmaf(pc, r2, 1.0f / 40320.0f);
    pc = fmaf(pc, r2, -1.0f / 720.0f); pc = fmaf(pc, r2, 1.0f / 24.0f); pc = fmaf(pc, r2, -0.5f);
    c = sgn * fmaf(pc, r2, 1.0f);
}
__device__ __forceinline__ float rope_inv(int i) { return exp2f(-(float)i * (13.287712379549449f / 16.0f)); }

__device__ __forceinline__ void p0_tile(const float* __restrict__ W, int ldw, int k0, int n0, bf16* WT, int ldk, int drow0, int koff, LAS float* scr, int lane) {
    const int n4 = lane & 15, kq = lane >> 4;
    f32x4 v[16];
#pragma unroll
    for (int i = 0; i < 16; ++i) v[i] = *(const f32x4*)(W + (size_t)(k0 + 4 * i + kq) * ldw + n0 + 4 * n4);
#pragma unroll
    for (int i = 0; i < 16; ++i) { const int kk = 4 * i + kq;
        scr[(4 * n4 + 0) * 65 + kk] = v[i].x; scr[(4 * n4 + 1) * 65 + kk] = v[i].y; scr[(4 * n4 + 2) * 65 + kk] = v[i].z; scr[(4 * n4 + 3) * 65 + kk] = v[i].w; }
    LDS_WAIT();
    const int c = lane & 7;
#pragma unroll
    for (int j = 0; j < 8; ++j) { const int n = (lane >> 3) + 8 * j; const LAS float* s = scr + n * 65 + 8 * c;
        u32x4 o; o.x = cvt_pk_bf16(s[0], s[1]); o.y = cvt_pk_bf16(s[2], s[3]); o.z = cvt_pk_bf16(s[4], s[5]); o.w = cvt_pk_bf16(s[6], s[7]);
        *(u32x4*)(WT + (size_t)(drow0 + n) * ldk + koff + k0 + 8 * c) = o; }
    LDS_WAIT();
}

struct EpiIn {
    static constexpr bool PERM = true, AFTER_DRAIN = false, HAS_MID = false;
    float* cq; float* ckvr; float* kpe; float* ub; bf16* sza; bf16* szb; bf16* sga; bf16* sgb;
    __device__ __forceinline__ void operator()(const f32x4 (&acc)[2][2][4][2], const pg8::Unit& u, int wr, int wc, int fr, int fq) const {
        const int pn = u.pn;
        int mode, ld, cb, ncol = 256; float* fp = nullptr; bf16* bp = nullptr;
        if (pn < 4) { mode = 0; fp = cq; ld = QL; cb = pn * 256; }
        else if (pn < 6) { mode = 0; fp = ckvr; ld = KVL; cb = (pn - 4) * 256; }
        else if (pn < 7) { mode = 0; fp = kpe; ld = RD; cb = 0; ncol = 64; }
        else if (pn < 15) { mode = 1; bp = sza; ld = MLAW; cb = (pn - 7) * 256; }
        else if (pn < 23) { mode = 0; fp = ub; ld = S5W; cb = (pn - 15) * 256; }
        else if (pn < 31) { mode = 1; bp = szb; ld = S5W; cb = (pn - 23) * 256; }
        else if (pn < 47) { mode = 2; bp = sga; ld = DM; cb = (pn - 31) * 256; }
        else { mode = 2; bp = sgb; ld = DM; cb = (pn - 47) * 256; }
        const int row0 = u.pm * 256 + wr * 64 + fr, c0 = wc * 32 + 8 * fq;
#pragma unroll
        for (int ai = 0; ai < 2; ++ai)
#pragma unroll
            for (int m = 0; m < 4; ++m) { const size_t row = (size_t)(row0 + ai * 128 + m * 16);
#pragma unroll
                for (int bj = 0; bj < 2; ++bj) { const int c = bj * 128 + c0; const f32x4 v0 = acc[ai][bj][m][0], v1 = acc[ai][bj][m][1];
                    if (mode == 0) { if (c < ncol) { float* p = fp + row * ld + cb + c; *(f32x4*)p = v0; *(f32x4*)(p + 4) = v1; } }
                    else { float a[8] = {v0[0], v0[1], v0[2], v0[3], v1[0], v1[1], v1[2], v1[3]};
#pragma unroll
                        for (int e = 0; e < 8; ++e) { const float sg = sigmoidf_(a[e]); a[e] = (mode == 1) ? a[e] * sg : sg; }
                        u32x4 w; w.x = cvt_pk_bf16(a[0], a[1]); w.y = cvt_pk_bf16(a[2], a[3]); w.z = cvt_pk_bf16(a[4], a[5]); w.w = cvt_pk_bf16(a[6], a[7]);
                        *(u32x4*)(bp + row * ld + cb + c) = w; } } }
    }
};
struct EpiStore {
    static constexpr bool PERM = true, AFTER_DRAIN = false, HAS_MID = false;
    bf16* O; int ldc;
    __device__ __forceinline__ void operator()(const f32x4 (&acc)[2][2][4][2], const pg8::Unit& u, int wr, int wc, int fr, int fq) const {
        const int row0 = u.pm * 256 + wr * 64 + fr, c0 = u.pn * 256 + wc * 32 + 8 * fq;
#pragma unroll
        for (int ai = 0; ai < 2; ++ai)
#pragma unroll
            for (int m = 0; m < 4; ++m) { bf16* rp = O + (size_t)(row0 + ai * 128 + m * 16) * ldc + c0;
#pragma unroll
                for (int bj = 0; bj < 2; ++bj) { const f32x4 v0 = acc[ai][bj][m][0], v1 = acc[ai][bj][m][1];
                    u32x4 w; w.x = cvt_pk_bf16(v0[0], v0[1]); w.y = cvt_pk_bf16(v0[2], v0[3]); w.z = cvt_pk_bf16(v1[0], v1[1]); w.w = cvt_pk_bf16(v1[2], v1[3]);
                    *(u32x4*)(rp + bj * 128) = w; } }
    }
};
struct EpiGlu {
    static constexpr bool PERM = true, AFTER_DRAIN = false, HAS_MID = false;
    const bf16* y5; const bf16* szb; const float* bglu; bf16* ab;
    __device__ __forceinline__ void operator()(const f32x4 (&acc)[2][2][4][2], const pg8::Unit& u, int wr, int wc, int fr, int fq) const {
        const int row0 = u.pm * 256 + wr * 64 + fr, c0 = u.pn * 256 + wc * 32 + 8 * fq;
#pragma unroll
        for (int bj = 0; bj < 2; ++bj) { const int c = c0 + bj * 128; const f32x4 b0 = *(const f32x4*)(bglu + c), b1 = *(const f32x4*)(bglu + c + 4);
#pragma unroll
            for (int ai = 0; ai < 2; ++ai)
#pragma unroll
                for (int m = 0; m < 4; ++m) { const size_t row = (size_t)(row0 + ai * 128 + m * 16);
                    const u32x4 yv = *(const u32x4*)(y5 + row * S5W + c), zv = *(const u32x4*)(szb + row * S5W + c);
                    const f32x4 v0 = acc[ai][bj][m][0] + b0, v1 = acc[ai][bj][m][1] + b1;
                    float r[8];
                    r[0] = bflo(yv.x) * sigmoidf_(v0[0]) * bflo(zv.x); r[1] = bfhi(yv.x) * sigmoidf_(v0[1]) * bfhi(zv.x);
                    r[2] = bflo(yv.y) * sigmoidf_(v0[2]) * bflo(zv.y); r[3] = bfhi(yv.y) * sigmoidf_(v0[3]) * bfhi(zv.y);
                    r[4] = bflo(yv.z) * sigmoidf_(v1[0]) * bflo(zv.z); r[5] = bfhi(yv.z) * sigmoidf_(v1[1]) * bfhi(zv.z);
                    r[6] = bflo(yv.w) * sigmoidf_(v1[2]) * bflo(zv.w); r[7] = bfhi(yv.w) * sigmoidf_(v1[3]) * bfhi(zv.w);
                    u32x4 w; w.x = cvt_pk_bf16(r[0], r[1]); w.y = cvt_pk_bf16(r[2], r[3]); w.z = cvt_pk_bf16(r[4], r[5]); w.w = cvt_pk_bf16(r[6], r[7]);
                    *(u32x4*)(ab + row * DM + MLAW + c) = w; } }
    }
};
struct EpiMerge {
    static constexpr bool PERM = true, AFTER_DRAIN = false, HAS_MID = true;
    const bf16* sga; const bf16* sgb; bf16* mg;
    __device__ __forceinline__ void mid(f32x4 (&acc)[2][2][4][2], const pg8::Unit& u, int wr, int wc, int fr, int fq) const {
        int zero_; asm volatile("v_mov_b32 %0, 0" : "=v"(zero_));
        const int row0 = u.pm * 256 + wr * 64 + fr + zero_, c0 = u.pn * 256 + wc * 32 + 8 * fq;
#pragma unroll
        for (int ai = 0; ai < 2; ++ai)
#pragma unroll
            for (int m = 0; m < 4; ++m) { const size_t row = (size_t)(row0 + ai * 128 + m * 16);
#pragma unroll
                for (int bj = 0; bj < 2; ++bj) { const int c = c0 + bj * 128;
                    const u32x4 av = *(const u32x4*)(sga + row * DM + c), bv = *(const u32x4*)(sgb + row * DM + c);
                    f32x4 r0, r1;
                    r0[0] = bflo(av.x) * fast_rcp(bflo(bv.x)); r0[1] = bfhi(av.x) * fast_rcp(bfhi(bv.x)); r0[2] = bflo(av.y) * fast_rcp(bflo(bv.y)); r0[3] = bfhi(av.y) * fast_rcp(bfhi(bv.y));
                    r1[0] = bflo(av.z) * fast_rcp(bflo(bv.z)); r1[1] = bfhi(av.z) * fast_rcp(bfhi(bv.z)); r1[2] = bflo(av.w) * fast_rcp(bflo(bv.w)); r1[3] = bfhi(av.w) * fast_rcp(bfhi(bv.w));
                    acc[ai][bj][m][0] = acc[ai][bj][m][0] * r0; acc[ai][bj][m][1] = acc[ai][bj][m][1] * r1; }
                asm volatile("" ::: "memory"); }
    }
    __device__ __forceinline__ void operator()(const f32x4 (&acc)[2][2][4][2], const pg8::Unit& u, int wr, int wc, int fr, int fq) const {
        int zero_; asm volatile("v_mov_b32 %0, 0" : "=v"(zero_));
        const int row0 = u.pm * 256 + wr * 64 + fr + zero_, c0 = u.pn * 256 + wc * 32 + 8 * fq;
#pragma unroll
        for (int ai = 0; ai < 2; ++ai)
#pragma unroll
            for (int m = 0; m < 4; ++m) { const size_t row = (size_t)(row0 + ai * 128 + m * 16);
#pragma unroll
                for (int bj = 0; bj < 2; ++bj) { const int c = c0 + bj * 128; const f32x4 v0 = acc[ai][bj][m][0], v1 = acc[ai][bj][m][1];
                    const u32x4 bv = *(const u32x4*)(sgb + row * DM + c);
                    u32x4 w; w.x = cvt_pk_bf16(v0[0] * bflo(bv.x), v0[1] * bfhi(bv.x)); w.y = cvt_pk_bf16(v0[2] * bflo(bv.y), v0[3] * bfhi(bv.y));
                    w.z = cvt_pk_bf16(v1[0] * bflo(bv.z), v1[1] * bfhi(bv.z)); w.w = cvt_pk_bf16(v1[2] * bflo(bv.w), v1[3] * bfhi(bv.w));
                    *(u32x4*)(mg + row * DM + c) = w; } }
    }
};
struct EpiOut {
    static constexpr bool PERM = true, AFTER_DRAIN = false, HAS_MID = false;
    const float* xp; const float* xs; const float* gate; float* out;
    __device__ __forceinline__ void operator()(const f32x4 (&acc)[2][2][4][2], const pg8::Unit& u, int wr, int wc, int fr, int fq) const {
        const int rt = u.pm * 256; const int cond = rt < NP ? 0 : (rt < NP + 1024 ? 1 : 2);
        const float* xb = rt < NP ? xp : xs - (size_t)NP * DM;
        const int row0 = rt + wr * 64 + fr, c0 = u.pn * 256 + wc * 32 + 8 * fq;
#pragma unroll
        for (int bj = 0; bj < 2; ++bj) { const int c = c0 + bj * 128; const f32x4 g0 = *(const f32x4*)(gate + cond * DM + c), g1 = *(const f32x4*)(gate + cond * DM + c + 4);
#pragma unroll
            for (int ai = 0; ai < 2; ++ai)
#pragma unroll
                for (int m = 0; m < 4; ++m) { const size_t off = (size_t)(row0 + ai * 128 + m * 16) * DM + c;
                    const f32x4 x0 = *(const f32x4*)(xb + off), x1 = *(const f32x4*)(xb + off + 4);
                    *(f32x4*)(out + off) = x0 * ALPHA + g0 * acc[ai][bj][m][0]; *(f32x4*)(out + off + 4) = x1 * ALPHA + g1 * acc[ai][bj][m][1]; } }
    }
};

constexpr int S5_WLDS = 10240 + 4352 + 1024;
__device__ __forceinline__ void s5_task(const float* ub, float* ys, int row0, int L, int g, int d,
                                        const float* __restrict__ a_re, const float* __restrict__ a_im, const float* __restrict__ log_dt,
                                        const float* __restrict__ b_re, const float* __restrict__ b_im, const float* __restrict__ c_re, const float* __restrict__ c_im,
                                        const float* h0re, const float* h0im, float* fre, float* fim, LAS unsigned char* wl, int lane) {
    LAS float* BuS = (LAS float*)wl; LAS unsigned char* Xs = wl + 10240; LAS float* par = (LAS float*)(wl + 10240 + 4352);
    const int fr = lane & 15, fq = lane >> 4;
    const int pg = d * 128 + g;
    float abr, abi;
    {
        const float ar = a_re[pg * 64 + lane], ai = a_im[pg * 64 + lane], dt = __expf(log_dt[pg]);
        const float mag = __expf(dt * ar); float sn, cs; sincos_acc(dt * ai, sn, cs);
        abr = mag * cs; abi = mag * sn;
        const float den = ar * ar + ai * ai, pr = abr - 1.0f;
        const float qr = (pr * ar + abi * ai) / den, qi = (abi * ar - pr * ai) / den;
        par[lane] = qr; par[64 + lane] = qi;
    }
    LDS_WAIT();
    bf16x8 Bre[4], Bim[4];
#pragma unroll
    for (int nb = 0; nb < 4; ++nb) { const int n = 16 * nb + fr; const float qr = par[n], qi = par[64 + n];
        const float* br = b_re + ((size_t)pg * 64 + n) * 16 + 8 * (fq & 1); const float* bi = b_im + ((size_t)pg * 64 + n) * 16 + 8 * (fq & 1);
        const f32x4 r0 = *(const f32x4*)br, r1 = *(const f32x4*)(br + 4), i0 = *(const f32x4*)bi, i1 = *(const f32x4*)(bi + 4);
        const f32x4 e0 = r0 * qr - i0 * qi, e1 = r1 * qr - i1 * qi, f0 = i0 * qr + r0 * qi, f1 = i1 * qr + r1 * qi;
        u32x4 wr_, wi_; wr_.x = cvt_pk_bf16(e0[0], e0[1]); wr_.y = cvt_pk_bf16(e0[2], e0[3]); wr_.z = cvt_pk_bf16(e1[0], e1[1]); wr_.w = cvt_pk_bf16(e1[2], e1[3]);
        wi_.x = cvt_pk_bf16(f0[0], f0[1]); wi_.y = cvt_pk_bf16(f0[2], f0[3]); wi_.z = cvt_pk_bf16(f1[0], f1[1]); wi_.w = cvt_pk_bf16(f1[2], f1[3]);
        Bre[nb] = __builtin_bit_cast(bf16x8, wr_); Bim[nb] = __builtin_bit_cast(bf16x8, wi_); }
    bf16x8 Cf[4];
#pragma unroll
    for (int ks = 0; ks < 4; ++ks) { const float* cp = ((ks < 2) ? c_re : c_im) + ((size_t)pg * 16 + fr) * 64 + 32 * (ks & 1) + 8 * fq; const float sg = (ks < 2) ? 1.0f : -1.0f;
        const f32x4 v0 = *(const f32x4*)cp * sg, v1 = *(const f32x4*)(cp + 4) * sg;
        u32x4 w; w.x = cvt_pk_bf16(v0[0], v0[1]); w.y = cvt_pk_bf16(v0[2], v0[3]); w.z = cvt_pk_bf16(v1[0], v1[1]); w.w = cvt_pk_bf16(v1[2], v1[3]);
        Cf[ks] = __builtin_bit_cast(bf16x8, w); }
    float xr = 0.f, xi = 0.f;
    if (h0re) { xr = h0re[lane]; xi = h0im[lane]; }
    const int nch = L >> 4;
    const float* ucol = ub + (size_t)g * 16 + 8 * (fq & 1);
    f32x4 un0, un1;
    { const int t0 = d ? (L - 16) : 0; const float* up = ucol + (size_t)(row0 + t0 + fr) * S5W; un0 = *(const f32x4*)up; un1 = *(const f32x4*)(up + 4); }
    for (int ch = 0; ch < nch; ++ch) {
        const int t0 = d ? (L - 16 - 16 * ch) : 16 * ch;
        const f32x4 u0 = un0, u1 = un1;
        if (ch + 1 < nch) { const int t1 = d ? (t0 - 16) : (t0 + 16); const float* up = ucol + (size_t)(row0 + t1 + fr) * S5W; un0 = *(const f32x4*)up; un1 = *(const f32x4*)(up + 4); }
        float uu[8] = {u0[0], u0[1], u0[2], u0[3], u1[0], u1[1], u1[2], u1[3]};
        if (fq >= 2) {
#pragma unroll
            for (int e = 0; e < 8; ++e) uu[e] = uu[e] - bf2f(f2bf(uu[e]));
        }
        u32x4 aw; aw.x = cvt_pk_bf16(uu[0], uu[1]); aw.y = cvt_pk_bf16(uu[2], uu[3]); aw.z = cvt_pk_bf16(uu[4], uu[5]); aw.w = cvt_pk_bf16(uu[6], uu[7]);
        const bf16x8 Af = __builtin_bit_cast(bf16x8, aw);
#pragma unroll
        for (int nb = 0; nb < 4; ++nb) {
            const f32x4 z = {0.f, 0.f, 0.f, 0.f};
            const f32x4 br = __builtin_amdgcn_mfma_f32_16x16x32_bf16(Af, Bre[nb], z, 0, 0, 0);
            const f32x4 bi = __builtin_amdgcn_mfma_f32_16x16x32_bf16(Af, Bim[nb], z, 0, 0, 0);
            *(LAS f32x4*)(BuS + (16 * nb + fr) * 20 + 4 * fq) = br;
            *(LAS f32x4*)(BuS + 1280 + (16 * nb + fr) * 20 + 4 * fq) = bi;
        }
        LDS_WAIT();
#pragma unroll
        for (int jj = 0; jj < 4; ++jj) { const int j = d ? (3 - jj) : jj;
            const f32x4 vr = *(const LAS f32x4*)(BuS + lane * 20 + 4 * j), vi = *(const LAS f32x4*)(BuS + 1280 + lane * 20 + 4 * j);
#pragma unroll
            for (int ii = 0; ii < 4; ++ii) { const int i = d ? (3 - ii) : ii;
                const float nr = fmaf(abr, xr, fmaf(-abi, xi, vr[i])), ni = fmaf(abr, xi, fmaf(abi, xr, vi[i]));
                xr = nr; xi = ni;
                const int t = 4 * j + i;
                *(LAS unsigned short*)(Xs + t * 272 + lane * 2) = (unsigned short)f2bf(xr);
                *(LAS unsigned short*)(Xs + t * 272 + 128 + lane * 2) = (unsigned short)f2bf(xi); } }
        LDS_WAIT();
        f32x4 y = {0.f, 0.f, 0.f, 0.f};
#pragma unroll
        for (int ks = 0; ks < 4; ++ks) { const bf16x8 xa = *(const LAS bf16x8*)(Xs + fr * 272 + (32 * ks + 8 * fq) * 2);
            y = __builtin_amdgcn_mfma_f32_16x16x32_bf16(xa, Cf[ks], y, 0, 0, 0); }
        float* yp = ys + (size_t)(row0 + t0 + 4 * fq) * S5W + g * 16 + fr;
        yp[0] = y[0]; yp[S5W] = y[1]; yp[2 * S5W] = y[2]; yp[3 * S5W] = y[3];
        LDS_WAIT();
    }
    if (fre) { fre[lane] = xr; fim[lane] = xi; }
}

constexpr int ATT_KB = 64 * 400, ATT_VB = 128 * 144, ATT_BUF = ATT_KB + ATT_VB;
__device__ __forceinline__ void attn_unit(const bf16* Q, const bf16* KN, const bf16* KPEB, const bf16* VT, const bf16* sza, bf16* ab,
                                          int qrow0, int h, int nt, int nt1, int key1, int key2, int rope_t0  ,
                                          LAS unsigned char* lds, int tid, int wave, int lane) {
    const int fr = lane & 15, fq = lane >> 4;
    bf16x8 qf[2][6];
#pragma unroll
    for (int qb = 0; qb < 2; ++qb) { const bf16* qp = Q + (size_t)(qrow0 + 32 * wave + 16 * qb + fr) * 3072 + h * 192 + 8 * fq;
#pragma unroll
        for (int ks = 0; ks < 6; ++ks) qf[qb][ks] = __builtin_bit_cast(bf16x8, *(const u32x4*)(qp + 32 * ks)); }
    if (rope_t0 >= 0) {
#pragma unroll
        for (int qb = 0; qb < 2; ++qb) { const int tq = rope_t0 + 32 * wave + 16 * qb + fr;
#pragma unroll
            for (int half = 0; half < 2; ++half) { const float pos = (float)(half == 0 ? (tq >> 6) : (tq & 63));
                u32x4 w = __builtin_bit_cast(u32x4, qf[qb][4 + half]);
                float v[8] = {bflo(w.x), bfhi(w.x), bflo(w.y), bfhi(w.y), bflo(w.z), bfhi(w.z), bflo(w.w), bfhi(w.w)};
                float o[8];
#pragma unroll
                for (int j = 0; j < 8; ++j) { const float pv = __shfl_xor(v[j], 32);
                    float sn, cs; sincos_acc(pos * rope_inv(8 * (fq & 1) + j), sn, cs);
                    o[j] = (fq < 2) ? (v[j] * cs - pv * sn) : (v[j] * cs + pv * sn); }
                w.x = cvt_pk_bf16(o[0], o[1]); w.y = cvt_pk_bf16(o[2], o[3]); w.z = cvt_pk_bf16(o[4], o[5]); w.w = cvt_pk_bf16(o[6], o[7]);
                qf[qb][4 + half] = __builtin_bit_cast(bf16x8, w); } }
    }
    f32x4 oacc[2][8];
#pragma unroll
    for (int qb = 0; qb < 2; ++qb)
#pragma unroll
        for (int db = 0; db < 8; ++db) oacc[qb][db] = (f32x4){0.f, 0.f, 0.f, 0.f};
    float mrun[2] = {-1e30f, -1e30f}, lrun[2] = {0.f, 0.f};
    const float SC = 0.07216878364870322f * 1.4426950408889634f;
    u32x4 sk0, sk1, sp, sv0, sv1;
    const int kr = tid >> 4, kc = tid & 15;
    const int pr = tid >> 3, pc = tid & 7;
    const int vr = tid >> 3, vc = tid & 7;
#define ATT_LOAD(t) do { const int key0_ = ((t) < nt1) ? key1 + 64 * (t) : key2 + 64 * ((t) - nt1); \
        sk0 = *(const u32x4*)(KN + (size_t)(key0_ + kr) * 2048 + h * 128 + 8 * kc); sk1 = *(const u32x4*)(KN + (size_t)(key0_ + kr + 32) * 2048 + h * 128 + 8 * kc); \
        sp = *(const u32x4*)(KPEB + (size_t)(key0_ + pr) * 64 + 8 * pc); \
        sv0 = *(const u32x4*)(VT + (size_t)(h * 128 + vr) * NKV + key0_ + 8 * vc); sv1 = *(const u32x4*)(VT + (size_t)(h * 128 + vr + 64) * NKV + key0_ + 8 * vc); } while (0)
#define ATT_STORE(b) do { LAS unsigned char* kb_ = lds + (b) * ATT_BUF; LAS unsigned char* vb_ = kb_ + ATT_KB; \
        *(LAS u32x4*)(kb_ + kr * 400 + kc * 16) = sk0; *(LAS u32x4*)(kb_ + (kr + 32) * 400 + kc * 16) = sk1; *(LAS u32x4*)(kb_ + pr * 400 + 256 + pc * 16) = sp; \
        *(LAS u32x4*)(vb_ + vr * 144 + vc * 16) = sv0; *(LAS u32x4*)(vb_ + (vr + 64) * 144 + vc * 16) = sv1; } while (0)
    ATT_LOAD(0); ATT_STORE(0);
    __syncthreads();
    for (int t = 0; t < nt; ++t) {
        if (t + 1 < nt) ATT_LOAD(t + 1);
        const LAS unsigned char* kb = lds + (t & 1) * ATT_BUF; const LAS unsigned char* vb = kb + ATT_KB;
        f32x4 s[2][4];
#pragma unroll
        for (int qb = 0; qb < 2; ++qb)
#pragma unroll
            for (int kb4 = 0; kb4 < 4; ++kb4) s[qb][kb4] = (f32x4){0.f, 0.f, 0.f, 0.f};
#pragma unroll
        for (int ks = 0; ks < 6; ++ks)
#pragma unroll
            for (int kb4 = 0; kb4 < 4; ++kb4) { const bf16x8 kf = *(const LAS bf16x8*)(kb + (16 * kb4 + fr) * 400 + (32 * ks + 8 * fq) * 2);
                s[0][kb4] = __builtin_amdgcn_mfma_f32_16x16x32_bf16(kf, qf[0][ks], s[0][kb4], 0, 0, 0);
                s[1][kb4] = __builtin_amdgcn_mfma_f32_16x16x32_bf16(kf, qf[1][ks], s[1][kb4], 0, 0, 0); }
        bf16x8 pf[2][2];
#pragma unroll
        for (int qb = 0; qb < 2; ++qb) {
            float mx = -1e30f;
#pragma unroll
            for (int kb4 = 0; kb4 < 4; ++kb4) { s[qb][kb4] = s[qb][kb4] * SC; mx = fmaxf(mx, fmaxf(fmaxf(s[qb][kb4][0], s[qb][kb4][1]), fmaxf(s[qb][kb4][2], s[qb][kb4][3]))); }
            mx = fmaxf(mx, __shfl_xor(mx, 16)); mx = fmaxf(mx, __shfl_xor(mx, 32));
            const float mnew = fmaxf(mrun[qb], mx), alpha = exp2f(mrun[qb] - mnew); mrun[qb] = mnew;
            float ps = 0.f;
#pragma unroll
            for (int kb4 = 0; kb4 < 4; ++kb4) {
#pragma unroll
                for (int i = 0; i < 4; ++i) { const float p = exp2f(s[qb][kb4][i] - mnew); s[qb][kb4][i] = p; ps += p; } }
            lrun[qb] = lrun[qb] * alpha + ps;
#pragma unroll
            for (int db = 0; db < 8; ++db) oacc[qb][db] = oacc[qb][db] * alpha;
#pragma unroll
            for (int kk = 0; kk < 2; ++kk) { u32x4 w; w.x = cvt_pk_bf16(s[qb][2 * kk][0], s[qb][2 * kk][1]); w.y = cvt_pk_bf16(s[qb][2 * kk][2], s[qb][2 * kk][3]);
                w.z = cvt_pk_bf16(s[qb][2 * kk + 1][0], s[qb][2 * kk + 1][1]); w.w = cvt_pk_bf16(s[qb][2 * kk + 1][2], s[qb][2 * kk + 1][3]);
                pf[qb][kk] = __builtin_bit_cast(bf16x8, w); }
        }
#pragma unroll
        for (int db = 0; db < 8; ++db)
#pragma unroll
            for (int kk = 0; kk < 2; ++kk) { const LAS unsigned char* vp = vb + (16 * db + fr) * 144 + (32 * kk + 4 * fq) * 2;
                const u32x2 lo = *(const LAS u32x2*)vp, hi = *(const LAS u32x2*)(vp + 32);
                u32x4 w; w.x = lo.x; w.y = lo.y; w.z = hi.x; w.w = hi.y; const bf16x8 vf = __builtin_bit_cast(bf16x8, w);
                oacc[0][db] = __builtin_amdgcn_mfma_f32_16x16x32_bf16(vf, pf[0][kk], oacc[0][db], 0, 0, 0);
                oacc[1][db] = __builtin_amdgcn_mfma_f32_16x16x32_bf16(vf, pf[1][kk], oacc[1][db], 0, 0, 0); }
        if (t + 1 < nt) ATT_STORE((t + 1) & 1);
        __syncthreads();
    }
#undef ATT_LOAD
#undef ATT_STORE
#pragma unroll
    for (int qb = 0; qb < 2; ++qb) { float l = lrun[qb]; l += __shfl_xor(l, 16); l += __shfl_xor(l, 32); const float inv = 1.0f / l;
        const size_t row = (size_t)(qrow0 + 32 * wave + 16 * qb + fr);
#pragma unroll
        for (int db = 0; db < 8; ++db) { const int dcol = h * 128 + 16 * db + 4 * fq; const u32x2 zv = *(const u32x2*)(sza + row * MLAW + dcol); const f32x4 o = oacc[qb][db] * inv;
            u32x2 w; w.x = cvt_pk_bf16(o[0] * bflo(zv.x), o[1] * bfhi(zv.x)); w.y = cvt_pk_bf16(o[2] * bflo(zv.y), o[3] * bfhi(zv.y));
            *(u32x2*)(ab + row * DM + dcol) = w; } }
}

#define XB_TMO      128
#define XB_XCNT(j)  (256  + 64 * (j))
#define XB_XSUB(j)  (1280 + 64 * (j))
#define XB_XGEN(j)  (2304 + 64 * (j))
#define XB_TOP      3328
#define XB_TOPGEN   3392
#define XCD_BAR_WORDS 3456
#define XB_SPIN_CAP (1u << 18)

__device__ __forceinline__ unsigned xb_ld(unsigned* p)              { return __hip_atomic_load(p, __ATOMIC_RELAXED, __HIP_MEMORY_SCOPE_AGENT); }
__device__ __forceinline__ unsigned xb_add(unsigned* p, unsigned v) { return __hip_atomic_fetch_add(p, v, __ATOMIC_RELAXED, __HIP_MEMORY_SCOPE_AGENT); }
__device__ __forceinline__ unsigned xb_xcc_id() { return (unsigned)__builtin_amdgcn_s_getreg((3 << 11) | 20) & 0xFu; }
#define XB_SPIN(cond, bar) do { unsigned _sp = 0; while (cond) { __builtin_amdgcn_s_sleep(1); \
    if ((++_sp & 255u) == 0u) { if (xb_ld(&(bar)[XB_TMO])) break; if (_sp > XB_SPIN_CAP) { atomicAdd(&(bar)[XB_TMO], 1u); break; } } } } while (0)

struct XcdBarrier {
    unsigned* bar; unsigned x;
    volatile LAS unsigned* st;
};

__device__ __forceinline__ XcdBarrier xcd_barrier_post(unsigned* bar, volatile LAS unsigned* st) {
    XcdBarrier b; b.bar = bar; b.x = xb_xcc_id(); b.st = st;
    if (threadIdx.x == 0) (void)xb_add(&bar[XB_XCNT(b.x)], 1u);
    return b;
}
__device__ __forceinline__ void xcd_barrier_complete(unsigned* bar, unsigned x, unsigned& nloc, unsigned& nx) {
    const unsigned G = gridDim.x * gridDim.y * gridDim.z;
    unsigned sum, cnt, mine, sp = 0u;
    for (;;) {
        sum = 0u; cnt = 0u; mine = 0u;
#pragma unroll
        for (unsigned j = 0; j < 16; ++j) { const unsigned c = xb_ld(&bar[XB_XCNT(j)]); sum += c; cnt += (c > 0u) ? 1u : 0u; mine = (j == x) ? c : mine; }
        if (sum == G) break;
        __builtin_amdgcn_s_sleep(1);
        if ((++sp & 255u) == 0u) { if (xb_ld(&bar[XB_TMO])) break; if (sp > XB_SPIN_CAP) { atomicAdd(&bar[XB_TMO], 1u); break; } }
    }
    nloc = mine > 0u ? mine : 1u; nx = cnt > 0u ? cnt : 1u;
}

__device__ __forceinline__ void xcd_barrier(const XcdBarrier& b) {
    asm volatile("s_waitcnt vmcnt(0)" ::: "memory");
    __syncthreads();
    if (threadIdx.x == 0) {
        unsigned* bar = b.bar;
        __builtin_amdgcn_s_waitcnt(0);
        unsigned nloc = b.st[0], nx = b.st[1];
        if (nloc == 0u) { xcd_barrier_complete(bar, b.x, nloc, nx); b.st[0] = nloc; b.st[1] = nx; }
        const unsigned old = xb_add(&bar[XB_XSUB(b.x)], 1u);
        const unsigned gen = old / nloc;
        if (old + 1u == (gen + 1u) * nloc) {
            __builtin_amdgcn_fence(__ATOMIC_RELEASE, "agent");
            asm volatile("s_waitcnt vmcnt(0)" ::: "memory");
            const unsigned og = xb_add(&bar[XB_TOP], 1u);
            const unsigned tg = og / nx;
            if (og + 1u == (tg + 1u) * nx) xb_add(&bar[XB_TOPGEN], 1u);
            else XB_SPIN(xb_ld(&bar[XB_TOPGEN]) == tg, bar);
            __builtin_amdgcn_fence(__ATOMIC_ACQUIRE, "agent");
            xb_add(&bar[XB_XGEN(b.x)], 1u);
            asm volatile("s_waitcnt vmcnt(0)" ::: "memory");
        } else {
            XB_SPIN(xb_ld(&bar[XB_XGEN(b.x)]) == gen, bar);
            __builtin_amdgcn_fence(__ATOMIC_ACQUIRE, "agent");
            asm volatile("s_waitcnt vmcnt(0)" ::: "memory");
        }
    }
    __syncthreads();
}

struct ListOrder {
    int n, pm0, pn0, pm1, pn1, pm2, pn2;
    __device__ __forceinline__ bool next(int i, pg8::Unit& u) const { if (i >= n) return false; u.pm = (i == 0) ? pm0 : ((i == 1) ? pm1 : pm2); u.pn = (i == 0) ? pn0 : ((i == 1) ? pn1 : pn2); return true; }
    __device__ __forceinline__ void a_ready(const pg8::Unit&) const {}
    __device__ __forceinline__ void done(const pg8::Unit&) const {}
};
struct Params { const float* in[30]; float* out; unsigned char* ws; };

__global__ void __launch_bounds__(NTHR, 2) hybrid_fwd(Params P) {
    extern __shared__ __attribute__((aligned(16))) unsigned char lds_raw[];
    LAS unsigned char* lds = (LAS unsigned char*)lds_raw;
    cg::grid_group grid = cg::this_grid();
    const int tid = threadIdx.x, lane = tid & 63, wave = __builtin_amdgcn_readfirstlane(tid >> 6);
    const int wg = blockIdx.x, G = gridDim.x;
    const int gw = wg * NWAVES + wave, NGW = G * NWAVES;
    unsigned char* ws = P.ws;
    const float* x_prompt = P.in[0]; const float* x_sample = P.in[1]; const float* cache_ckv = P.in[2]; const float* cache_kpe = P.in[3];
    const float* st_re = P.in[4]; const float* st_im = P.in[5]; const float* c_in = P.in[6]; const float* c_ctx = P.in[7];
    const float* w_ada = P.in[8]; const float* b_ada = P.in[9]; const float* w_in = P.in[10]; const float* g_qn = P.in[11]; const float* w_uq = P.in[12];
    const float* g_kvn = P.in[13]; const float* w_ukv = P.in[14];
    const float* s5_a_re = P.in[15]; const float* s5_a_im = P.in[16]; const float* s5_log_dt = P.in[17]; const float* s5_b_re = P.in[18]; const float* s5_b_im = P.in[19];
    const float* s5_c_re = P.in[20]; const float* s5_c_im = P.in[21]; const float* s5_d = P.in[22]; const float* w_glu = P.in[23]; const float* b_glu = P.in[24];
    const float* w_pa = P.in[25]; const float* w_pb = P.in[26]; const float* w_o = P.in[27]; const float* ln_g = P.in[28]; const float* ln_b = P.in[29];
    float* out = P.out;
    float* modp = (float*)(ws + WS_MODP); float* gatev = (float*)(ws + WS_MOD);
    bf16* WIN = (bf16*)(ws + WS_WIN); bf16* WUQ = (bf16*)(ws + WS_WUQ); bf16* WK = (bf16*)(ws + WS_WK); bf16* WV = (bf16*)(ws + WS_WV);
    bf16* WGLU = (bf16*)(ws + WS_WGLU); bf16* WPAB = (bf16*)(ws + WS_WPAB); bf16* WO = (bf16*)(ws + WS_WO);
    bf16* H = (bf16*)(ws + WS_H); float* CQ = (float*)(ws + WS_CQ); float* CKVR = (float*)(ws + WS_CKVR); float* KPE = (float*)(ws + WS_KPE); float* UB = (float*)(ws + WS_UB);
    bf16* SZA = (bf16*)(ws + WS_SZA); bf16* SZB = (bf16*)(ws + WS_SZB); bf16* SGA = (bf16*)(ws + WS_SGA); bf16* SGB = (bf16*)(ws + WS_SGB);
    bf16* CQN = (bf16*)(ws + WS_CQN); bf16* CKVB = (bf16*)(ws + WS_CKVB); bf16* KPEB = (bf16*)(ws + WS_KPEB);
    bf16* Q = (bf16*)(ws + WS_Q); bf16* KN = (bf16*)(ws + WS_KN); bf16* VT = (bf16*)(ws + WS_VT);
    float* YS5 = (float*)(ws + WS_YS5); bf16* Y5 = (bf16*)(ws + WS_Y5); bf16* AB = (bf16*)(ws + WS_AB); bf16* MG = (bf16*)(ws + WS_MG);

    volatile LAS unsigned* bst = (volatile LAS unsigned*)(lds + LDS_BYTES - 64);
    if (tid < 16) bst[tid] = 0u;
    __syncthreads();
    const XcdBarrier xbar = xcd_barrier_post((unsigned*)(ws + WS_CTL) + 1024, bst);
#define GRID_BAR() xcd_barrier(xbar)

    if constexpr ((PHASE_MASK >> 0) & 1)
    {
        LAS float* scr = (LAS float*)(lds + wave * 16640);
        constexpr int I_IN = 64 * 249, I_UQ = 16 * 48, I_UKV = 8 * 64, I_GLU = 32 * 32, I_PA = 32 * 64, I_PB = 32 * 64, I_O = 64 * 64;
        constexpr int NITEMS = I_IN + I_UQ + I_UKV + I_GLU + I_PA + I_PB + I_O;
        for (int it = gw; it < NITEMS; it += NGW) {
            int r = it;
            if (r < I_IN) { const int kb = r / 249, nb = r % 249, n0 = 64 * nb; p0_tile(w_in, INC, 64 * kb, n0, WIN, DM, n0 + (n0 >= 1600 ? 192 : 0), 0, scr, lane); continue; } r -= I_IN;
            if (r < I_UQ) { const int kb = r / 48, nb = r % 48; p0_tile(w_uq, 3072, 64 * kb, 64 * nb, WUQ, QL, 64 * nb, 0, scr, lane); continue; } r -= I_UQ;
            if (r < I_UKV) { const int kb = r / 64, nb = r % 64, hh = nb >> 2, jj = nb & 3;
                p0_tile(w_ukv, 4096, 64 * kb, 64 * nb, (jj < 2) ? WK : WV, KVL, hh * 128 + (jj & 1) * 64, 0, scr, lane); continue; } r -= I_UKV;
            if (r < I_GLU) { const int kb = r / 32, nb = r % 32; p0_tile(w_glu, S5W, 64 * kb, 64 * nb, WGLU, S5W, 64 * nb, 0, scr, lane); continue; } r -= I_GLU;
            if (r < I_PA) { const int kb = r / 64, nb = r % 64; p0_tile(w_pa, DM, 64 * kb, 64 * nb, WPAB, DM, 64 * nb, 0, scr, lane); continue; } r -= I_PA;
            if (r < I_PB) { const int kb = r / 64, nb = r % 64; p0_tile(w_pb, DM, 64 * kb, 64 * nb, WPAB, DM, 64 * nb, MLAW, scr, lane); continue; } r -= I_PB;
            { const int kb = r / 64, nb = r % 64; p0_tile(w_o, DM, 64 * kb, 64 * nb, WO, DM, 64 * nb, 0, scr, lane); }
        }
        for (int i = wg * NTHR + tid; i < (1024 * KVL) / 4; i += G * NTHR) { const f32x4 v = *(const f32x4*)(cache_ckv + 4 * (size_t)i);
            u32x2 w; w.x = cvt_pk_bf16(v[0], v[1]); w.y = cvt_pk_bf16(v[2], v[3]); *(u32x2*)(CKVB + (size_t)MT * KVL + 4 * (size_t)i) = w; }
        for (int i = wg * NTHR + tid; i < (1024 * RD) / 4; i += G * NTHR) { const f32x4 v = *(const f32x4*)(cache_kpe + 4 * (size_t)i);
            u32x2 w; w.x = cvt_pk_bf16(v[0], v[1]); w.y = cvt_pk_bf16(v[2], v[3]); *(u32x2*)(KPEB + (size_t)MT * RD + 4 * (size_t)i) = w; }
        __syncthreads();
        if (wg < 240) {
            const int slab = wg % 48, kc = wg / 48, k0 = (kc * 4096) / 5, k1 = ((kc + 1) * 4096) / 5;
            f32x4 a0 = {0.f, 0.f, 0.f, 0.f}, a1 = a0, a2 = a0;
            const float* wp = w_ada + slab * 256 + 4 * lane;
#pragma unroll 4
            for (int k = k0 + wave; k < k1; k += NWAVES) {
                const f32x4 w = *(const f32x4*)(wp + (size_t)k * 12288);
                const float s0 = siluf_(c_ctx[k]), s1 = siluf_(c_in[k]), s2 = siluf_(c_in[DM + k]);
                a0 += w * s0; a1 += w * s1; a2 += w * s2;
            }
            LAS f32x4* red = (LAS f32x4*)lds;
            red[(wave * 3 + 0) * 64 + lane] = a0; red[(wave * 3 + 1) * 64 + lane] = a1; red[(wave * 3 + 2) * 64 + lane] = a2;
            __syncthreads();
            if (tid < 192) { const int cnd = tid >> 6, l = tid & 63; f32x4 s = red[cnd * 64 + l];
#pragma unroll
                for (int w = 1; w < 8; ++w) s += red[(w * 3 + cnd) * 64 + l];
                *(f32x4*)(modp + ((size_t)kc * 3 + cnd) * 12288 + slab * 256 + 4 * l) = s; }
        }
    }
    grid.sync();

    if constexpr ((PHASE_MASK >> 1) & 1)
    {
        { const int i = wg * NTHR + tid; if (i < 3 * DM) { const int cnd = i / DM, col = i % DM; float s = b_ada[2 * DM + col];
#pragma unroll
                for (int kc = 0; kc < 5; ++kc) s += modp[((size_t)kc * 3 + cnd) * 12288 + 2 * DM + col];
                gatev[i] = s; } }
        LAS float* sh = (LAS float*)lds; LAS float* sc1 = sh + DM;
        int cur_c = -1;
        for (int u = wg; u < 768; u += G) {
            const int cnd = u < 512 ? 0 : (u < 640 ? 1 : 2);
            if (cnd != cur_c) {
                __syncthreads();
                for (int col = tid; col < DM; col += NTHR) { float s = b_ada[col], t = b_ada[DM + col];
#pragma unroll
                    for (int kc = 0; kc < 5; ++kc) { s += modp[((size_t)kc * 3 + cnd) * 12288 + col]; t += modp[((size_t)kc * 3 + cnd) * 12288 + DM + col]; }
                    sh[col] = s; sc1[col] = 1.0f + t; }
                __syncthreads();
                cur_c = cnd;
            }
            const int row = 8 * u + wave;
            const float* xr = (row < NP) ? x_prompt + (size_t)row * DM : x_sample + (size_t)(row - NP) * DM;
            f32x4 v[16]; float s = 0.f;
#pragma unroll
            for (int j = 0; j < 16; ++j) { v[j] = *(const f32x4*)(xr + 4 * lane + 256 * j); s += (v[j][0] + v[j][1]) + (v[j][2] + v[j][3]); }
            const float mean = wave_sum(s) * (1.0f / DM); float s2 = 0.f;
#pragma unroll
            for (int j = 0; j < 16; ++j) { v[j] = v[j] - mean; s2 += (v[j][0] * v[j][0] + v[j][1] * v[j][1]) + (v[j][2] * v[j][2] + v[j][3] * v[j][3]); }
            const float rstd = 1.0f / sqrtf(wave_sum(s2) * (1.0f / DM) + LN_EPS);
            bf16* hr = H + (size_t)row * DM;
#pragma unroll
            for (int j = 0; j < 16; ++j) { const int col = 4 * lane + 256 * j; const f32x4 a = *(const LAS f32x4*)(sc1 + col), b = *(const LAS f32x4*)(sh + col);
                const f32x4 o = v[j] * rstd * a + b; u32x2 w; w.x = cvt_pk_bf16(o[0], o[1]); w.y = cvt_pk_bf16(o[2], o[3]); *(u32x2*)(hr + col) = w; }
        }
    }
    GRID_BAR();

    if constexpr ((PHASE_MASK >> 2) & 1)
    {
        pg8::Gemm g{H, WIN, MT, INP, DM}; pg8::StaticOrder S; S.init(MT, INP, G, wg);
        EpiIn E{CQ, CKVR, KPE, UB, SZA, SZB, SGA, SGB};
        pg8::gemm_phase<EpiIn, pg8::StaticOrder, true, true>(lds, g, S, E);
    }
    GRID_BAR();

    if constexpr ((PHASE_MASK >> 3) & 1)
    {
        for (int row = gw; row < MT; row += NGW) {
            {
                f32x4 v[4]; float s = 0.f;
#pragma unroll
                for (int j = 0; j < 4; ++j) { v[j] = *(const f32x4*)(CQ + (size_t)row * QL + 4 * lane + 256 * j); s += (v[j][0] * v[j][0] + v[j][1] * v[j][1]) + (v[j][2] * v[j][2] + v[j][3] * v[j][3]); }
                const float rs = 1.0f / sqrtf(wave_sum(s) * (1.0f / QL) + LN_EPS);
#pragma unroll
                for (int j = 0; j < 4; ++j) { const int col = 4 * lane + 256 * j; const f32x4 gq = *(const f32x4*)(g_qn + col); const f32x4 o = v[j] * rs * gq;
                    u32x2 w; w.x = cvt_pk_bf16(o[0], o[1]); w.y = cvt_pk_bf16(o[2], o[3]); *(u32x2*)(CQN + (size_t)row * QL + col) = w; }
            }
            {
                f32x4 v[2]; float s = 0.f;
#pragma unroll
                for (int j = 0; j < 2; ++j) { v[j] = *(const f32x4*)(CKVR + (size_t)row * KVL + 4 * lane + 256 * j); s += (v[j][0] * v[j][0] + v[j][1] * v[j][1]) + (v[j][2] * v[j][2] + v[j][3] * v[j][3]); }
                const float rs = 1.0f / sqrtf(wave_sum(s) * (1.0f / KVL) + LN_EPS);
#pragma unroll
                for (int j = 0; j < 2; ++j) { const int col = 4 * lane + 256 * j; const f32x4 gk = *(const f32x4*)(g_kvn + col); const f32x4 o = v[j] * rs * gk;
                    u32x2 w; w.x = cvt_pk_bf16(o[0], o[1]); w.y = cvt_pk_bf16(o[2], o[3]); *(u32x2*)(CKVB + (size_t)row * KVL + col) = w;
                    if (row < NP) *(f32x4*)(out + O_CKV + (size_t)row * KVL + col) = o; }
            }
            {
                const float kv = KPE[(size_t)row * RD + lane]; float o = kv;
                if (row < NP) out[O_KPE + (size_t)row * RD + lane] = kv;
                else { const int t = (row - NP) & 1023; const float pos = (float)((lane < 32) ? (t >> 6) : (t & 63)); const float pv = __shfl_xor(kv, 16);
                    float sn, cs; sincos_acc(pos * rope_inv(lane & 15), sn, cs);
                    o = ((lane & 16) == 0) ? (kv * cs - pv * sn) : (kv * cs + pv * sn); }
                KPEB[(size_t)row * RD + lane] = (bf16)f2bf(o);
            }
        }
        LAS unsigned char* wl = lds + wave * S5_WLDS;
        if (wave < 2) {
            const int id = wg * 2 + wave;
            if (id < 512) { const int b = id >> 8, g = (id & 255) >> 1, d = id & 1;
                s5_task(UB, YS5 + (size_t)d * MT * S5W, NP + b * 1024, 1024, g, d, s5_a_re, s5_a_im, s5_log_dt, s5_b_re, s5_b_im, s5_c_re, s5_c_im,
                        st_re + ((size_t)(b * 2 + d) * 128 + g) * 64, st_im + ((size_t)(b * 2 + d) * 128 + g) * 64, nullptr, nullptr, wl, lane); }
        } else {
            for (int j = 0; j < 3; ++j) { const int pid = wg * 6 + (wave - 2) + 1536 * j;
                if (pid < 4096) { const int d = pid & 1, pgi = pid >> 1, b = pgi >> 7, g = pgi & 127;
                    s5_task(UB, YS5 + (size_t)d * MT * S5W, b * 256, 256, g, d, s5_a_re, s5_a_im, s5_log_dt, s5_b_re, s5_b_im, s5_c_re, s5_c_im,
                            nullptr, nullptr, out + O_SRE + ((size_t)(b * 2 + d) * 128 + g) * 64, out + O_SIM + ((size_t)(b * 2 + d) * 128 + g) * 64, wl, lane); } }
        }
        VM_WAIT();
        __syncthreads();
        for (int pi = 0; pi < 10; ++pi) {
            int row0, L, g;
            if (pi == 0) { if (wg >= 256) continue; row0 = NP + (wg >> 7) * 1024; L = 1024; g = wg & 127; }
            else { const int pp = (pi - 1) % 3, j = (pi - 1) / 3; const int pgi = wg * 3 + pp + 768 * j; if (pgi >= 2048) continue; row0 = (pgi >> 7) * 256; L = 256; g = pgi & 127; }
            for (int it = tid; it < L * 4; it += NTHR) { const int t = it >> 2, q4 = it & 3; const size_t off = (size_t)(row0 + t) * S5W + g * 16 + 4 * q4;
                const f32x4 u = *(const f32x4*)(UB + off), y0 = *(const f32x4*)(YS5 + off), y1 = *(const f32x4*)(YS5 + (size_t)MT * S5W + off), dk = *(const f32x4*)(s5_d + g * 16 + 4 * q4);
                const f32x4 y = dk * u + y0 + y1;
                u32x2 w; w.x = cvt_pk_bf16(gelu_tanh(y[0]), gelu_tanh(y[1])); w.y = cvt_pk_bf16(gelu_tanh(y[2]), gelu_tanh(y[3])); *(u32x2*)(Y5 + off) = w; }
        }
    }
    GRID_BAR();

    if constexpr ((PHASE_MASK >> 4) & 1)
    {
        { ListOrder S{}; if (wg < 192) { S.n = 1; S.pm0 = wg % 24; S.pn0 = wg / 24; }
          pg8::Gemm g{Y5, WGLU, MT, S5W, S5W}; EpiGlu E{Y5, SZB, b_glu, AB};
          pg8::gemm_phase<EpiGlu, ListOrder, true, true>(lds, g, S, E); }
        __syncthreads();
        { ListOrder S{}; if (wg >= 192) { const int t0 = 2 * (wg - 192); S.n = 2; S.pm0 = t0 % 24; S.pn0 = t0 / 24; S.pm1 = (t0 + 1) % 24; S.pn1 = (t0 + 1) / 24; }
          else if (wg < 160) { const int t0 = 128 + wg; S.n = 1; S.pm0 = t0 % 24; S.pn0 = t0 / 24; }
          pg8::Gemm g{CQN, WUQ, MT, 3072, QL}; EpiStore E{Q, 3072};
          pg8::gemm_phase<EpiStore, ListOrder, true, true>(lds, g, S, E); }
        __syncthreads();
        const int id0 = (wg >= 160) ? 3 * (wg - 160) : 288 + wg, nid = (wg >= 160) ? 3 : 1;
        { ListOrder S{}; int n = 0;
          for (int k = 0; k < nid; ++k) { const int id = id0 + k; if (id < 224) { const int pm = id % 28, pn = id / 28; if (n == 0) { S.pm0 = pm; S.pn0 = pn; } else if (n == 1) { S.pm1 = pm; S.pn1 = pn; } else { S.pm2 = pm; S.pn2 = pn; } ++n; } }
          S.n = n;
          pg8::Gemm g{CKVB, WK, NKV, 2048, KVL}; EpiStore E{KN, 2048};
          pg8::gemm_phase<EpiStore, ListOrder, true, true>(lds, g, S, E); }
        __syncthreads();
        { ListOrder S{}; int n = 0;
          for (int k = 0; k < nid; ++k) { const int id = id0 + k - 224; if (id >= 0) { const int pm = id % 8, pn = id / 8; if (n == 0) { S.pm0 = pm; S.pn0 = pn; } else if (n == 1) { S.pm1 = pm; S.pn1 = pn; } else { S.pm2 = pm; S.pn2 = pn; } ++n; } }
          S.n = n;
          pg8::Gemm g{WV, CKVB, 2048, NKV, KVL}; EpiStore E{VT, NKV};
          pg8::gemm_phase<EpiStore, ListOrder, true, true>(lds, g, S, E); }
    }
    GRID_BAR();

    if constexpr ((PHASE_MASK >> 5) & 1)
    {
        for (int rnd = 0; rnd < 2; ++rnd) {
            int qrow0, h, nt, nt1, key1, key2, rope_t0;
            if (wg < 128) { if (rnd) break; const int b = wg >> 6, hq = wg & 63; h = hq >> 2; const int qb = hq & 3;
                qrow0 = NP + b * 1024 + qb * 256; nt = 24; nt1 = 16; key1 = NP + b * 1024; key2 = MT + b * 512; rope_t0 = qb * 256; }
            else { const int uid = (wg - 128) * 2 + rnd; if (uid >= 256) break; const int b = uid >> 4; h = uid & 15;
                qrow0 = b * 256; nt = 4; nt1 = 4; key1 = b * 256; key2 = 0; rope_t0 = -1; }
            attn_unit(Q, KN, KPEB, VT, SZA, AB, qrow0, h, nt, nt1, key1, key2, rope_t0, lds, tid, wave, lane);
            __syncthreads();
        }
    }
    GRID_BAR();

    if constexpr ((PHASE_MASK >> 6) & 1)
    {
        const int x = wg & 7, i = wg >> 3, pl = i & 3, cl = i >> 2;
        const pg8::Gemm g6{AB, WPAB, MT, DM, DM}; const EpiMerge E6{SGA, SGB, MG};
        const pg8::Gemm g7{MG, WO, MT, DM, DM}; const EpiOut E7{x_prompt, x_sample, gatev, out};
        { ListOrder S{}; S.n = 1; S.pm0 = 4 * (x >> 1) + pl; S.pn0 = 8 * (x & 1) + cl;
          pg8::gemm_phase<EpiMerge, ListOrder, true, true>(lds, g6, S, E6); }
        GRID_BAR();
        if (x < 4) { ListOrder S{}; S.n = 1; S.pm0 = 16 + 4 * (x >> 1) + pl; S.pn0 = 8 * (x & 1) + cl;
          pg8::gemm_phase<EpiMerge, ListOrder, true, true>(lds, g6, S, E6); }
        else { const int y = x - 4; ListOrder S{}; S.n = 1; S.pm0 = 4 * (y >> 1) + pl; S.pn0 = 8 * (y & 1) + cl;
          pg8::gemm_phase<EpiOut, ListOrder, true, true>(lds, g7, S, E7); }
        GRID_BAR();
        { ListOrder S{}; S.n = 1; S.pm0 = 8 + 4 * (x >> 1) + pl; S.pn0 = 8 * (x & 1) + cl;
          pg8::gemm_phase<EpiOut, ListOrder, true, true>(lds, g7, S, E7); }
    }
    GRID_BAR();

    if constexpr ((PHASE_MASK >> 8) & 1)
    for (int row = gw; row < MT; row += NGW) {
        float* zr = out + (size_t)row * DM;
        f32x4 v[16]; float s = 0.f;
#pragma unroll
        for (int j = 0; j < 16; ++j) { v[j] = *(const f32x4*)(zr + 4 * lane + 256 * j); s += (v[j][0] + v[j][1]) + (v[j][2] + v[j][3]); }
        const float mean = wave_sum(s) * (1.0f / DM); float s2 = 0.f;
#pragma unroll
        for (int j = 0; j < 16; ++j) { v[j] = v[j] - mean; s2 += (v[j][0] * v[j][0] + v[j][1] * v[j][1]) + (v[j][2] * v[j][2] + v[j][3] * v[j][3]); }
        const float rstd = 1.0f / sqrtf(wave_sum(s2) * (1.0f / DM) + LN_EPS);
#pragma unroll
        for (int j = 0; j < 16; ++j) { const int col = 4 * lane + 256 * j; const f32x4 gg = *(const f32x4*)(ln_g + col), bb = *(const f32x4*)(ln_b + col);
            *(f32x4*)(zr + col) = v[j] * rstd * gg + bb; }
    }
}

extern "C" void kernel_launch(void* const* d_in, const int* in_sizes, int n_in, void* d_out, int out_size, void* d_ws, size_t ws_size, hipStream_t stream) {
    static int grid = 0;
    if (grid == 0) {
        if (n_in != 30 || ws_size < WS_END) { fprintf(stderr, "kernel_launch: need 30 inputs and %zu bytes of workspace; got %d, %zu\n", (size_t)WS_END, n_in, ws_size); grid = -1; return; }
        int dev = 0, cus = 0, per_cu = 0;
        hipGetDevice(&dev); hipDeviceGetAttribute(&cus, hipDeviceAttributeMultiprocessorCount, dev);
        if (hipFuncSetAttribute((const void*)hybrid_fwd, hipFuncAttributeMaxDynamicSharedMemorySize, LDS_BYTES) != hipSuccess) { fprintf(stderr, "kernel_launch: hipFuncSetAttribute failed\n"); grid = -1; return; }
        hipOccupancyMaxActiveBlocksPerMultiprocessor(&per_cu, (const void*)hybrid_fwd, NTHR, LDS_BYTES);
        (void)hipGetLastError();
        if (per_cu < 1) { fprintf(stderr, "kernel_launch: occupancy query says %d blocks per CU\n", per_cu); per_cu = 1; }
        grid = cus;
        if (grid != 256) { fprintf(stderr, "kernel_launch: built for a 256-CU device (got %d)\n", cus); grid = -1; return; }
    }
    if (grid < 0) return;
    if (hipMemsetAsync((char*)d_ws + WS_CTL, 0, CTL_ZERO_BYTES, stream) != hipSuccess) { fprintf(stderr, "kernel_launch: memset failed\n"); return; }
    Params p{};
    for (int i = 0; i < 30; ++i) p.in[i] = (const float*)d_in[i];
    p.out = (float*)d_out; p.ws = (unsigned char*)d_ws;
    void* args[] = {&p};
    hipError_t e = hipLaunchCooperativeKernel((const void*)hybrid_fwd, dim3(grid), dim3(NTHR), args, LDS_BYTES, stream);
    if (e != hipSuccess) fprintf(stderr, "cooperative launch failed: %s (grid %d)\n", hipGetErrorString(e), grid);
}
```

```cpp
#include <hip/hip_runtime.h>
#include <hip/hip_cooperative_groups.h>
#include <cstdio>
#include <cstdint>
namespace cg = cooperative_groups;
namespace pg8 {
#define PG8_LAS __attribute__((address_space(3)))
typedef unsigned short bf16_t;
typedef short bf16x8 __attribute__((ext_vector_type(8)));
typedef float f32x4 __attribute__((ext_vector_type(4)));
typedef unsigned u32x4 __attribute__((ext_vector_type(4)));
constexpr int BM = 256, BK = 64, HALF = 128, HTB = HALF * BK * 2  , STAGE_BYTES = 8 * HTB, NXCD = 8, WGM = 8;

__host__ __device__ __forceinline__ int lds_byte(int r, int c) { const int st = (r >> 4) * 2 + (c >> 5), rr = r & 15, cc = c & 31, ob = rr * 64 + cc * 2; return st * 1024 + (ob ^ (((ob >> 9) & 1) << 5)); }
__host__ __device__ __forceinline__ void stage_rc(int b, int& R, int& C) { const int st = b / 1024, sb = b % 1024, swz = sb ^ (((sb >> 9) & 1) << 5); R = (st >> 1) * 16 + swz / 64; C = (st & 1) * 32 + (swz % 64) / 2; }
__host__ __device__ __forceinline__ int perm32(int rho) { const int n = rho >> 4, i = rho & 15; return 8 * (i >> 2) + 4 * n + (i & 3); }

struct Unit { int pm, pn; };
struct Gemm { const bf16_t* A; const bf16_t* Bt; int M, N, K; };

struct StaticOrder {
    int nM, nN, nwg, G, c;
    __host__ __device__ void init(int M, int N, int G_, int c_) { nM = M / BM; nN = N / BM; nwg = nM * nN; G = G_; c = c_; }
    __host__ __device__ bool next(int i, Unit& u) const {
        const long L = (long)i * G + c; if (L >= nwg) return false;
        int wgid = (int)L; { const int q = nwg / NXCD, r = nwg % NXCD, xcd = wgid % NXCD, off = wgid / NXCD; wgid = (xcd < r ? xcd * (q + 1) : r * (q + 1) + (xcd - r) * q) + off; }
        const int nig = WGM * nN, gid = wgid / nig, fm = gid * WGM, gsz = (nM - fm) < WGM ? (nM - fm) : WGM;
        u.pm = fm + ((wgid % nig) % gsz); u.pn = (wgid % nig) / gsz; return true;
    }
    __device__ __forceinline__ void a_ready(const Unit&) const {}
    __device__ __forceinline__ void done(const Unit&) const {}
};

__device__ __forceinline__ unsigned cvt_pk_bf16(float lo, float hi) { unsigned r; asm volatile("v_cvt_pk_bf16_f32 %0, %1, %2" : "=v"(r) : "v"(lo), "v"(hi)); return r; }
typedef float f32x2 __attribute__((ext_vector_type(2)));
typedef int i32x8 __attribute__((ext_vector_type(8)));
typedef int i32x4v __attribute__((ext_vector_type(4)));
__device__ __forceinline__ i32x8 cat8(bf16x8 lo, bf16x8 hi) { const i32x4v a = __builtin_bit_cast(i32x4v, lo), b = __builtin_bit_cast(i32x4v, hi); return __builtin_shufflevector(a, b, 0, 1, 2, 3, 4, 5, 6, 7); }
template <class Epi, class Sched, bool ALIGN_EPI = false, bool SP2 = false, bool FP8 = false>
__device__ __forceinline__ void gemm_phase(PG8_LAS unsigned char* lds, const Gemm g, const Sched& S, const Epi& E) {
    int tid_ = threadIdx.x; asm volatile("" : "+v"(tid_));
    const int tid = tid_, wid = __builtin_amdgcn_readfirstlane(tid >> 6), lane = tid & 63, wr = wid >> 2, wc = wid & 3, fr = lane & 15, fq = lane >> 4;
    const int K = g.K, nt = K / BK;
    unsigned voffA[2], voffB[2];
#pragma unroll
    for (int i = 0; i < 2; ++i) { int R, C; stage_rc(tid * 16 + i * 8192, R, C); const int Rb = Epi::PERM ? ((R & ~31) + perm32(R & 31)) : R;
        voffA[i] = (unsigned)(R * K + C) * 2u; voffB[i] = (unsigned)(Rb * K + C) * 2u; }
    const size_t kstep = (size_t)(BK * 2);
    const size_t hstep = (size_t)HALF * K * 2;
    const size_t tstep = 2 * hstep;
    const unsigned ldsw = (unsigned)wid * 1024u;
    const int aoff = lds_byte(wr * 64 + fr, fq * 8), boff = lds_byte(wc * 32 + fr, fq * 8);
#define PG8_SA(b, h) (((b) * 2 + (h)) * HTB)
#define PG8_SB(b, h) ((4 + (b) * 2 + (h)) * HTB)
#define PG8_STAGE(bufoff, gbase, voff) do { _Pragma("unroll") for (int _i = 0; _i < 2; ++_i) \
        __builtin_amdgcn_global_load_lds((const unsigned*)((const char*)(gbase) + (voff)[_i]), (PG8_LAS unsigned*)(lds + (bufoff) + ldsw + _i * 8192), 16, 0, 0); } while (0)
#define PG8_LDA(dst, b, h) do { if constexpr (FP8) { _Pragma("unroll") for (int m = 0; m < 4; ++m) dst##8[m] = cat8(*(const PG8_LAS bf16x8*)(lds + PG8_SA(b, h) + aoff + m * 2048), *(const PG8_LAS bf16x8*)(lds + PG8_SA(b, h) + aoff + m * 2048 + 1024)); } \
        else { _Pragma("unroll") for (int m = 0; m < 4; ++m) _Pragma("unroll") for (int k = 0; k < 2; ++k) dst[m][k] = *(const PG8_LAS bf16x8*)(lds + PG8_SA(b, h) + aoff + m * 2048 + k * 1024); } } while (0)
#define PG8_LDB(dst, b, h) do { if constexpr (FP8) { _Pragma("unroll") for (int n = 0; n < 2; ++n) dst##8[n] = cat8(*(const PG8_LAS bf16x8*)(lds + PG8_SB(b, h) + boff + n * 2048), *(const PG8_LAS bf16x8*)(lds + PG8_SB(b, h) + boff + n * 2048 + 1024)); } \
        else { _Pragma("unroll") for (int n = 0; n < 2; ++n) _Pragma("unroll") for (int k = 0; k < 2; ++k) dst[n][k] = *(const PG8_LAS bf16x8*)(lds + PG8_SB(b, h) + boff + n * 2048 + k * 1024); } } while (0)
#define PG8_MMA(ai, bj, At, Bt) do { __builtin_amdgcn_s_setprio(1); \
        if constexpr (FP8) { _Pragma("unroll") for (int m = 0; m < 4; ++m) _Pragma("unroll") for (int n = 0; n < 2; ++n) \
            asm volatile("v_mfma_f32_16x16x128_f8f6f4 %0, %1, %2, %0" : "+v"(acc[ai][bj][m][n]) : "v"(Bt##8[n]), "v"(At##8[m])); } \
        else { _Pragma("unroll") for (int m = 0; m < 4; ++m) _Pragma("unroll") for (int n = 0; n < 2; ++n) _Pragma("unroll") for (int k = 0; k < 2; ++k) \
            acc[ai][bj][m][n] = __builtin_amdgcn_mfma_f32_16x16x32_bf16(Bt[n][k], At[m][k], acc[ai][bj][m][n], 0, 0, 0); } \
        __builtin_amdgcn_s_setprio(0); } while (0)
#define PG8_WAIT_V(n) asm volatile("s_waitcnt vmcnt(" #n ")" ::: "memory")
#define PG8_WAIT_L(n) asm volatile("s_waitcnt lgkmcnt(" #n ")" ::: "memory")
#define PG8_BAR __builtin_amdgcn_s_barrier()
#define PG8_SCHED __builtin_amdgcn_sched_barrier(0)
    Unit cur, nxt; int ui = 0;
    if (!S.next(0, cur)) return;
    f32x4 acc[2][2][4][2];
#pragma unroll
    for (int a = 0; a < 2; ++a)
#pragma unroll
        for (int b = 0; b < 2; ++b)
#pragma unroll
            for (int m = 0; m < 4; ++m)
#pragma unroll
                for (int n = 0; n < 2; ++n) acc[a][b][m][n] = (f32x4){0.f, 0.f, 0.f, 0.f};
    bf16x8 At[4][2], B0[2][2], B1[2][2];
    i32x8 At8[4], B08[2], B18[2];
    const char* cA = (const char*)g.A + (size_t)cur.pm * tstep; const char* cB = (const char*)g.Bt + (size_t)cur.pn * tstep;
    S.a_ready(cur);
    if constexpr (SP2) {
        PG8_STAGE(PG8_SB(0, 0), cB, voffB); PG8_STAGE(PG8_SB(0, 1), cB + hstep, voffB); PG8_STAGE(PG8_SA(0, 0), cA, voffA); PG8_STAGE(PG8_SA(0, 1), cA + hstep, voffA);
        if (wr == 1) PG8_BAR;
        PG8_WAIT_V(2); PG8_BAR;
        PG8_STAGE(PG8_SB(1, 0), cB + kstep, voffB); PG8_STAGE(PG8_SA(1, 0), cA + kstep, voffA); PG8_STAGE(PG8_SB(1, 1), cB + hstep + kstep, voffB);
        PG8_WAIT_V(6); PG8_BAR;
    } else {
        PG8_STAGE(PG8_SB(0, 0), cB, voffB); PG8_STAGE(PG8_SA(0, 0), cA, voffA); PG8_STAGE(PG8_SB(0, 1), cB + hstep, voffB); PG8_STAGE(PG8_SA(0, 1), cA + hstep, voffA);
        if (wr == 1) PG8_BAR;
        PG8_WAIT_V(4); PG8_BAR;
        PG8_STAGE(PG8_SB(1, 0), cB + kstep, voffB); PG8_STAGE(PG8_SA(1, 0), cA + kstep, voffA); PG8_STAGE(PG8_SB(1, 1), cB + hstep + kstep, voffB);
        PG8_WAIT_V(6); PG8_BAR;
    }
    for (;;) {
        const bool has_next = S.next(ui + 1, nxt);
        const char* nA = has_next ? (const char*)g.A + (size_t)nxt.pm * tstep : cA; const char* nB = has_next ? (const char*)g.Bt + (size_t)nxt.pn * tstep : cB;
        for (int t = 0; t < nt; t += 2) {
            const bool last = (t == nt - 2);
            if constexpr (Epi::HAS_MID) { if (t == (nt >> 1)) { if constexpr (FP8) asm volatile("s_nop 7\n\ts_nop 7\n\ts_nop 7" ::: "memory"); E.mid(acc, cur, wr, wc, fr, fq); } }
            const char* a1 = cA + (size_t)(t + 1) * kstep;
            const char* a2 = last ? nA : cA + (size_t)(t + 2) * kstep; const char* b2 = last ? nB : cB + (size_t)(t + 2) * kstep;
            const char* a3 = a2 + kstep; const char* b3 = b2 + kstep;
            if (last && has_next) S.a_ready(nxt);
            if constexpr (SP2) {
            PG8_LDB(B0, 0, 0); PG8_LDB(B1, 0, 1); PG8_SCHED; PG8_LDA(At, 0, 0); PG8_STAGE(PG8_SA(1, 1), a1 + hstep, voffA);
            PG8_WAIT_V(8); PG8_WAIT_L(0); PG8_BAR; PG8_MMA(0, 0, At, B0); PG8_MMA(0, 1, At, B1); PG8_BAR; PG8_SCHED;
            PG8_LDA(At, 0, 1); PG8_STAGE(PG8_SB(0, 0), b2, voffB); PG8_STAGE(PG8_SB(0, 1), b2 + hstep, voffB); PG8_STAGE(PG8_SA(0, 0), a2, voffA);
            PG8_WAIT_V(8); PG8_WAIT_L(0); PG8_BAR; PG8_MMA(1, 0, At, B0); PG8_MMA(1, 1, At, B1); PG8_BAR; PG8_SCHED;
            PG8_LDB(B0, 1, 0); PG8_LDB(B1, 1, 1); PG8_SCHED; PG8_LDA(At, 1, 0); PG8_STAGE(PG8_SA(0, 1), a2 + hstep, voffA);
            PG8_WAIT_V(8); PG8_WAIT_L(0); PG8_BAR; PG8_MMA(0, 0, At, B0); PG8_MMA(0, 1, At, B1); PG8_BAR; PG8_SCHED;
            PG8_LDA(At, 1, 1); PG8_STAGE(PG8_SB(1, 0), b3, voffB); PG8_STAGE(PG8_SB(1, 1), b3 + hstep, voffB); PG8_STAGE(PG8_SA(1, 0), a3, voffA);
            PG8_WAIT_V(8); PG8_WAIT_L(0); PG8_BAR; PG8_MMA(1, 0, At, B0); PG8_MMA(1, 1, At, B1); PG8_BAR; PG8_SCHED;
            } else {
            PG8_LDB(B0, 0, 0); PG8_SCHED; PG8_LDA(At, 0, 0); PG8_STAGE(PG8_SA(1, 1), a1 + hstep, voffA);
            PG8_WAIT_L(8); PG8_BAR; PG8_WAIT_L(0); PG8_MMA(0, 0, At, B0); PG8_BAR; PG8_SCHED;
            PG8_LDB(B1, 0, 1); PG8_STAGE(PG8_SB(0, 0), b2, voffB);
            PG8_BAR; PG8_WAIT_L(0); PG8_MMA(0, 1, At, B1); PG8_BAR;
            PG8_LDA(At, 0, 1); PG8_STAGE(PG8_SA(0, 0), a2, voffA);
            PG8_BAR; PG8_WAIT_L(0); PG8_MMA(1, 0, At, B0); PG8_BAR; PG8_SCHED;
            PG8_STAGE(PG8_SB(0, 1), b2 + hstep, voffB);
            PG8_WAIT_V(6); PG8_BAR; PG8_MMA(1, 1, At, B1); PG8_BAR;
            PG8_LDB(B0, 1, 0); PG8_SCHED; PG8_LDA(At, 1, 0); PG8_STAGE(PG8_SA(0, 1), a2 + hstep, voffA);
            PG8_WAIT_L(8); PG8_BAR; PG8_WAIT_L(0); PG8_MMA(0, 0, At, B0); PG8_BAR; PG8_SCHED;
            PG8_LDB(B1, 1, 1); PG8_STAGE(PG8_SB(1, 0), b3, voffB);
            PG8_BAR; PG8_WAIT_L(0); PG8_MMA(0, 1, At, B1); PG8_BAR;
            PG8_LDA(At, 1, 1); PG8_STAGE(PG8_SA(1, 0), a3, voffA);
            PG8_BAR; PG8_WAIT_L(0); PG8_MMA(1, 0, At, B0); PG8_BAR; PG8_SCHED;
            PG8_STAGE(PG8_SB(1, 1), b3 + hstep, voffB);
            PG8_WAIT_V(6); PG8_BAR; PG8_MMA(1, 1, At, B1); PG8_BAR;
            }
        }
        if constexpr (ALIGN_EPI) { if (wr == 0) PG8_BAR; }
        if constexpr (FP8) asm volatile("s_nop 7\n\ts_nop 7\n\ts_nop 7" ::: "memory");
        if constexpr (!Epi::AFTER_DRAIN) { E(acc, cur, wr, wc, fr, fq); S.done(cur); }
        if (!has_next) break;
#pragma unroll
        for (int a = 0; a < 2; ++a)
#pragma unroll
            for (int b = 0; b < 2; ++b)
#pragma unroll
                for (int m = 0; m < 4; ++m)
#pragma unroll
                    for (int n = 0; n < 2; ++n) acc[a][b][m][n] = (f32x4){0.f, 0.f, 0.f, 0.f};
        cur = nxt; cA = nA; cB = nB; ++ui;
        if constexpr (ALIGN_EPI) { if (wr == 1) PG8_BAR; }
    }
    PG8_WAIT_V(0);
    if constexpr (!ALIGN_EPI) { if (wr == 0) PG8_BAR; }
    PG8_BAR;
    if constexpr (Epi::AFTER_DRAIN) { E.fused(acc, cur, wr, wc, fr, fq, lds, wid, lane); S.done(cur); }
#undef PG8_SA
#undef PG8_SB
#undef PG8_STAGE
#undef PG8_LDA
#undef PG8_LDB
#undef PG8_MMA
#undef PG8_WAIT_V
#undef PG8_WAIT_L
#undef PG8_BAR
#undef PG8_SCHED
}
}

#define LAS __attribute__((address_space(3)))
typedef unsigned short bf16;
typedef float f32x4 __attribute__((ext_vector_type(4)));
typedef unsigned u32x4 __attribute__((ext_vector_type(4)));
typedef unsigned u32x2 __attribute__((ext_vector_type(2)));
typedef short bf16x8 __attribute__((ext_vector_type(8)));
using pg8::cvt_pk_bf16;

constexpr int NWAVES = 8, NTHR = 512;
constexpr int DM = 4096, NP = 4096, NS = 2048, MT = 6144, NKV = 7168;
constexpr int QL = 1024, KVL = 512, RD = 64, MLAW = 2048, S5W = 2048;
constexpr int INC = 15936, INP = 16128;
constexpr float LN_EPS = 1e-6f;
constexpr float ALPHA = 1.189207115002721f;

constexpr size_t MiB = 1u << 20;
constexpr size_t WS_CTL = 0, CTL_ZERO_BYTES = 64 * 1024;
constexpr size_t WS_MODP = 1 * MiB;
constexpr size_t WS_MOD = WS_MODP + 768 * 1024;
constexpr size_t WS_WIN8 = 2 * MiB;
constexpr size_t WS_WINB = 66 * MiB;
constexpr size_t WS_WUQ8 = 88 * MiB;
constexpr size_t WS_WK8 = 91 * MiB;
constexpr size_t WS_WV8 = 92 * MiB;
constexpr size_t WS_WGLU8 = 93 * MiB;
constexpr size_t WS_WPAB8 = 97 * MiB;
constexpr size_t WS_WO8 = 113 * MiB;
constexpr size_t WS_H8 = 130 * MiB;
constexpr size_t WS_H = 154 * MiB;
constexpr size_t WS_CQ = 186 * MiB;
constexpr size_t WS_CKVR = 210 * MiB;
constexpr size_t WS_KPE = 222 * MiB;
constexpr size_t WS_UB = 224 * MiB;
constexpr size_t WS_SZA = 272 * MiB;
constexpr size_t WS_SZB = 296 * MiB;
constexpr size_t WS_SGA = 320 * MiB;
constexpr size_t WS_SGB = 368 * MiB;
constexpr size_t WS_CQN8 = 416 * MiB;
constexpr size_t WS_CKV8 = 422 * MiB;
constexpr size_t WS_KPEB = 426 * MiB;
constexpr size_t WS_Q = 428 * MiB;
constexpr size_t WS_KN = 464 * MiB;
constexpr size_t WS_VT = 492 * MiB;
constexpr size_t WS_YS5 = 520 * MiB;
constexpr size_t WS_Y5 = 616 * MiB;
constexpr size_t WS_Y58 = 640 * MiB;
constexpr size_t WS_AB8 = 652 * MiB;
constexpr size_t WS_MG8 = 676 * MiB;
constexpr size_t WS_END = 700 * MiB;
constexpr float S_WIN = 64.f, S_WUQ = 32.f, S_WKV = 16.f, S_WGLU = 32.f, S_WP = 64.f, S_WO = 64.f, S_Y5 = 4.f, S_AB = 4.f, S_MG = 16.f;

constexpr size_t O_Y = 0, O_CKV = (size_t)MT * DM, O_KPE = O_CKV + (size_t)NP * KVL, O_SRE = O_KPE + (size_t)NP * RD, O_SIM = O_SRE + 16 * 2 * 128 * 64;

constexpr int LDS_BYTES = 147456;
#ifndef PHASE_MASK
#define PHASE_MASK 0x1ff
#endif

#define LDS_WAIT() asm volatile("s_waitcnt lgkmcnt(0)" ::: "memory")
#define VM_WAIT() asm volatile("s_waitcnt vmcnt(0)" ::: "memory")

__device__ __forceinline__ unsigned f2bf(float f) { unsigned u = __builtin_bit_cast(unsigned, f); return (u + 0x7fffu + ((u >> 16) & 1u)) >> 16; }
__device__ __forceinline__ float bf2f(unsigned b) { return __builtin_bit_cast(float, b << 16); }
__device__ __forceinline__ float bflo(unsigned w) { return __builtin_bit_cast(float, w << 16); }
__device__ __forceinline__ float bfhi(unsigned w) { return __builtin_bit_cast(float, w & 0xffff0000u); }
__device__ __forceinline__ float clamp8(float x) { return __builtin_amdgcn_fmed3f(x, -448.0f, 448.0f); }
__device__ __forceinline__ unsigned pk_fp8x4(float a, float b, float c, float d) {
    int r = __builtin_amdgcn_cvt_pk_fp8_f32(clamp8(a), clamp8(b), 0, false); r = __builtin_amdgcn_cvt_pk_fp8_f32(clamp8(c), clamp8(d), r, true); return (unsigned)r; }
__device__ __forceinline__ float fast_rcp(float x) { return __builtin_amdgcn_rcpf(x); }
__device__ __forceinline__ float sigmoidf_(float x) { return fast_rcp(1.0f + __expf(-x)); }
__device__ __forceinline__ float siluf_(float x) { return x * sigmoidf_(x); }
__device__ __forceinline__ float gelu_tanh(float x) {
    const float z = 0.7978845608028654f * (x + 0.044715f * x * x * x);
    const float t = 1.0f - 2.0f * fast_rcp(__expf(2.0f * z) + 1.0f);
    return 0.5f * x * (1.0f + t);
}
__device__ __forceinline__ float wave_sum(float v) {
#pragma unroll
    for (int o = 1; o < 64; o <<= 1) v += __shfl_xor(v, o);
    return v;
}
__device__ __forceinline__ void sincos_acc(float x, float& s, float& c) {
    const float k = rintf(x * 0.15915494309189535f);
    float r = fmaf(-k, 6.2831854820251465f, x);
    r = fmaf(-k, -1.7484555e-7f, r);
    float sgn = 1.0f;
    if (r > 1.5707963267948966f) { r = 3.14159274101257324f - r; r += -8.742278e-8f; sgn = -1.0f; }
    else if (r < -1.5707963267948966f) { r = -3.14159274101257324f - r; r -= -8.742278e-8f; sgn = -1.0f; }
    const float r2 = r * r;
    float ps = 1.0f / 6227020800.0f;
    ps = fmaf(ps, r2, -1.0f / 39916800.0f); ps = fmaf(ps, r2, 1.0f / 362880.0f); ps = fmaf(ps, r2, -1.0f / 5040.0f);
    ps = fmaf(ps, r2, 1.0f / 120.0f); ps = fmaf(ps, r2, -1.0f / 6.0f);
    s = fmaf(ps * r2, r, r);
    float pc = -1.0f / 87178291200.0f;
    pc = fmaf(pc, r2, 1.0f / 479001600.0f); pc = fmaf(pc, r2, -1.0f / 3628800.0f); pc = fmaf(pc, r2, 1.0f / 40320.0f);
    pc = fmaf(pc, r2, -1.0f / 720.0f); pc = fmaf(pc, r2, 1.0f / 24.0f); pc = fmaf(pc, r2, -0.5f);
    c = sgn * fmaf(pc, r2, 1.0f);
}
__device__ __forceinline__ float rope_inv(int i) { return exp2f(-(float)i * (13.287712379549449f / 16.0f)); }

__device__ __forceinline__ void p0_tile(const float* __restrict__ W, int ldw, int k0, int n0, unsigned char* W8, bf16* WB, float sc, int ldk, int drow0, int koff, LAS float* scr, int lane) {
    const int n4 = lane & 15, kq = lane >> 4;
    f32x4 v[16];
#pragma unroll
    for (int i = 0; i < 16; ++i) v[i] = *(const f32x4*)(W + (size_t)(k0 + 4 * i + kq) * ldw + n0 + 4 * n4);
#pragma unroll
    for (int i = 0; i < 16; ++i) { const int kk = 4 * i + kq;
        scr[(4 * n4 + 0) * 65 + kk] = v[i].x; scr[(4 * n4 + 1) * 65 + kk] = v[i].y; scr[(4 * n4 + 2) * 65 + kk] = v[i].z; scr[(4 * n4 + 3) * 65 + kk] = v[i].w; }
    LDS_WAIT();
    const int c = lane & 7;
#pragma unroll
    for (int j = 0; j < 8; ++j) { const int n = (lane >> 3) + 8 * j; const LAS float* s = scr + n * 65 + 8 * c;
        const float a0 = s[0], a1 = s[1], a2 = s[2], a3 = s[3], a4 = s[4], a5 = s[5], a6 = s[6], a7 = s[7];
        u32x2 q; q.x = pk_fp8x4(a0 * sc, a1 * sc, a2 * sc, a3 * sc); q.y = pk_fp8x4(a4 * sc, a5 * sc, a6 * sc, a7 * sc);
        *(u32x2*)(W8 + (size_t)(drow0 + n) * ldk + koff + k0 + 8 * c) = q;
        if (WB) { u32x4 o; o.x = cvt_pk_bf16(a0, a1); o.y = cvt_pk_bf16(a2, a3); o.z = cvt_pk_bf16(a4, a5); o.w = cvt_pk_bf16(a6, a7);
            *(u32x4*)(WB + (size_t)(drow0 + n) * ldk + koff + k0 + 8 * c) = o; } }
    LDS_WAIT();
}

struct EpiIn {
    static constexpr bool PERM = true, AFTER_DRAIN = false, HAS_MID = false;
    float* cq; float* ckvr; float* kpe; float* ub; bf16* sza; bf16* szb; bf16* sga; bf16* sgb; int pm_off, pn_off; float sc;
    __device__ __forceinline__ void operator()(const f32x4 (&acc)[2][2][4][2], const pg8::Unit& u, int wr, int wc, int fr, int fq) const {
        const int pn = u.pn + pn_off;
        int mode, ld, cb, ncol = 256; float* fp = nullptr; bf16* bp = nullptr;
        if (pn < 2) { mode = 0; fp = ckvr; ld = KVL; cb = pn * 256; }
        else if (pn < 3) { mode = 0; fp = kpe; ld = RD; cb = 0; ncol = 64; }
        else if (pn < 11) { mode = 0; fp = ub; ld = S5W; cb = (pn - 3) * 256; }
        else if (pn < 15) { mode = 0; fp = cq; ld = QL; cb = (pn - 11) * 256; }
        else if (pn < 23) { mode = 1; bp = sza; ld = MLAW; cb = (pn - 15) * 256; }
        else if (pn < 31) { mode = 1; bp = szb; ld = S5W; cb = (pn - 23) * 256; }
        else if (pn < 47) { mode = 2; bp = sga; ld = DM; cb = (pn - 31) * 256; }
        else { mode = 2; bp = sgb; ld = DM; cb = (pn - 47) * 256; }
        int zero_; asm volatile("v_mov_b32 %0, 0" : "=v"(zero_));
        const int row0 = (u.pm + pm_off) * 256 + wr * 64 + fr + zero_, c0 = wc * 32 + 8 * fq;
#pragma unroll
        for (int ai = 0; ai < 2; ++ai)
#pragma unroll
            for (int m = 0; m < 4; ++m) { const size_t row = (size_t)(row0 + ai * 128 + m * 16);
#pragma unroll
                for (int bj = 0; bj < 2; ++bj) { const int c = bj * 128 + c0; const f32x4 v0 = acc[ai][bj][m][0] * sc, v1 = acc[ai][bj][m][1] * sc;
                    if (mode == 0) { if (c < ncol) { float* p = fp + row * ld + cb + c; *(f32x4*)p = v0; *(f32x4*)(p + 4) = v1; } }
                    else { float a[8] = {v0[0], v0[1], v0[2], v0[3], v1[0], v1[1], v1[2], v1[3]};
#pragma unroll
                        for (int e = 0; e < 8; ++e) { const float sg = sigmoidf_(a[e]); a[e] = (mode == 1) ? a[e] * sg : sg; }
                        u32x4 w; w.x = cvt_pk_bf16(a[0], a[1]); w.y = cvt_pk_bf16(a[2], a[3]); w.z = cvt_pk_bf16(a[4], a[5]); w.w = cvt_pk_bf16(a[6], a[7]);
                        *(u32x4*)(bp + row * ld + cb + c) = w; } } }
    }
};
struct EpiStore {
    static constexpr bool PERM = true, AFTER_DRAIN = false, HAS_MID = false;
    bf16* O; int ldc; float sc;
    __device__ __forceinline__ void operator()(const f32x4 (&acc)[2][2][4][2], const pg8::Unit& u, int wr, int wc, int fr, int fq) const {
        int zero_; asm volatile("v_mov_b32 %0, 0" : "=v"(zero_));
        const int row0 = u.pm * 256 + wr * 64 + fr + zero_, c0 = u.pn * 256 + wc * 32 + 8 * fq;
#pragma unroll
        for (int ai = 0; ai < 2; ++ai)
#pragma unroll
            for (int m = 0; m < 4; ++m) { bf16* rp = O + (size_t)(row0 + ai * 128 + m * 16) * ldc + c0;
#pragma unroll
                for (int bj = 0; bj < 2; ++bj) { const f32x4 v0 = acc[ai][bj][m][0] * sc, v1 = acc[ai][bj][m][1] * sc;
                    u32x4 w; w.x = cvt_pk_bf16(v0[0], v0[1]); w.y = cvt_pk_bf16(v0[2], v0[3]); w.z = cvt_pk_bf16(v1[0], v1[1]); w.w = cvt_pk_bf16(v1[2], v1[3]);
                    *(u32x4*)(rp + bj * 128) = w; } }
    }
};
struct EpiGlu {
    static constexpr bool PERM = true, AFTER_DRAIN = false, HAS_MID = false;
    const bf16* y5; const bf16* szb; const float* bglu; unsigned char* ab8; float sc;
    __device__ __forceinline__ void operator()(const f32x4 (&acc)[2][2][4][2], const pg8::Unit& u, int wr, int wc, int fr, int fq) const {
        int zero_; asm volatile("v_mov_b32 %0, 0" : "=v"(zero_));
        const int row0 = u.pm * 256 + wr * 64 + fr + zero_, c0 = u.pn * 256 + wc * 32 + 8 * fq;
#pragma unroll
        for (int bj = 0; bj < 2; ++bj) { const int c = c0 + bj * 128; const f32x4 b0 = *(const f32x4*)(bglu + c), b1 = *(const f32x4*)(bglu + c + 4);
#pragma unroll
            for (int ai = 0; ai < 2; ++ai)
#pragma unroll
                for (int m = 0; m < 4; ++m) { const size_t row = (size_t)(row0 + ai * 128 + m * 16);
                    const u32x4 yv = *(const u32x4*)(y5 + row * S5W + c), zv = *(const u32x4*)(szb + row * S5W + c);
                    const f32x4 v0 = acc[ai][bj][m][0] * sc + b0, v1 = acc[ai][bj][m][1] * sc + b1;
                    float r[8];
                    r[0] = bflo(yv.x) * sigmoidf_(v0[0]) * bflo(zv.x); r[1] = bfhi(yv.x) * sigmoidf_(v0[1]) * bfhi(zv.x);
                    r[2] = bflo(yv.y) * sigmoidf_(v0[2]) * bflo(zv.y); r[3] = bfhi(yv.y) * sigmoidf_(v0[3]) * bfhi(zv.y);
                    r[4] = bflo(yv.z) * sigmoidf_(v1[0]) * bflo(zv.z); r[5] = bfhi(yv.z) * sigmoidf_(v1[1]) * bfhi(zv.z);
                    r[6] = bflo(yv.w) * sigmoidf_(v1[2]) * bflo(zv.w); r[7] = bfhi(yv.w) * sigmoidf_(v1[3]) * bfhi(zv.w);
                    u32x2 w; w.x = pk_fp8x4(r[0] * S_AB, r[1] * S_AB, r[2] * S_AB, r[3] * S_AB); w.y = pk_fp8x4(r[4] * S_AB, r[5] * S_AB, r[6] * S_AB, r[7] * S_AB);
                    *(u32x2*)(ab8 + row * DM + MLAW + c) = w; } }
    }
};
struct EpiMerge {
    static constexpr bool PERM = true, AFTER_DRAIN = false, HAS_MID = true;
    const bf16* sga; const bf16* sgb; unsigned char* mg8; float sc;
    __device__ __forceinline__ void mid(f32x4 (&acc)[2][2][4][2], const pg8::Unit& u, int wr, int wc, int fr, int fq) const {
        int zero_; asm volatile("v_mov_b32 %0, 0" : "=v"(zero_));
        const int row0 = u.pm * 256 + wr * 64 + fr + zero_, c0 = u.pn * 256 + wc * 32 + 8 * fq;
#pragma unroll
        for (int ai = 0; ai < 2; ++ai)
#pragma unroll
            for (int m = 0; m < 4; ++m) { const size_t row = (size_t)(row0 + ai * 128 + m * 16);
#pragma unroll
                for (int bj = 0; bj < 2; ++bj) { const int c = c0 + bj * 128;
                    const u32x4 av = *(const u32x4*)(sga + row * DM + c), bv = *(const u32x4*)(sgb + row * DM + c);
                    f32x4 r0, r1;
                    r0[0] = bflo(av.x) * fast_rcp(bflo(bv.x)); r0[1] = bfhi(av.x) * fast_rcp(bfhi(bv.x)); r0[2] = bflo(av.y) * fast_rcp(bflo(bv.y)); r0[3] = bfhi(av.y) * fast_rcp(bfhi(bv.y));
                    r1[0] = bflo(av.z) * fast_rcp(bflo(bv.z)); r1[1] = bfhi(av.z) * fast_rcp(bfhi(bv.z)); r1[2] = bflo(av.w) * fast_rcp(bflo(bv.w)); r1[3] = bfhi(av.w) * fast_rcp(bfhi(bv.w));
                    acc[ai][bj][m][0] = acc[ai][bj][m][0] * r0; acc[ai][bj][m][1] = acc[ai][bj][m][1] * r1; }
                asm volatile("" ::: "memory"); }
    }
    __device__ __forceinline__ void operator()(const f32x4 (&acc)[2][2][4][2], const pg8::Unit& u, int wr, int wc, int fr, int fq) const {
        int zero_; asm volatile("v_mov_b32 %0, 0" : "=v"(zero_));
        const int row0 = u.pm * 256 + wr * 64 + fr + zero_, c0 = u.pn * 256 + wc * 32 + 8 * fq;
#pragma unroll
        for (int ai = 0; ai < 2; ++ai)
#pragma unroll
            for (int m = 0; m < 4; ++m) { const size_t row = (size_t)(row0 + ai * 128 + m * 16);
#pragma unroll
                for (int bj = 0; bj < 2; ++bj) { const int c = c0 + bj * 128; const f32x4 v0 = acc[ai][bj][m][0] * sc, v1 = acc[ai][bj][m][1] * sc;
                    const u32x4 bv = *(const u32x4*)(sgb + row * DM + c);
                    u32x2 w; w.x = pk_fp8x4(v0[0] * bflo(bv.x), v0[1] * bfhi(bv.x), v0[2] * bflo(bv.y), v0[3] * bfhi(bv.y));
                    w.y = pk_fp8x4(v1[0] * bflo(bv.z), v1[1] * bfhi(bv.z), v1[2] * bflo(bv.w), v1[3] * bfhi(bv.w));
                    *(u32x2*)(mg8 + row * DM + c) = w; } }
    }
};
struct EpiOut {
    static constexpr bool PERM = true, AFTER_DRAIN = false, HAS_MID = false;
    const float* xp; const float* xs; const float* gate; float* out; float sc;
    __device__ __forceinline__ void operator()(const f32x4 (&acc)[2][2][4][2], const pg8::Unit& u, int wr, int wc, int fr, int fq) const {
        const int rt = u.pm * 256; const int cond = rt < NP ? 0 : (rt < NP + 1024 ? 1 : 2);
        const float* xb = rt < NP ? xp : xs - (size_t)NP * DM;
        int zero_; asm volatile("v_mov_b32 %0, 0" : "=v"(zero_));
        const int row0 = rt + wr * 64 + fr + zero_, c0 = u.pn * 256 + wc * 32 + 8 * fq;
#pragma unroll
        for (int bj = 0; bj < 2; ++bj) { const int c = c0 + bj * 128; const f32x4 g0 = *(const f32x4*)(gate + cond * DM + c) * sc, g1 = *(const f32x4*)(gate + cond * DM + c + 4) * sc;
#pragma unroll
            for (int ai = 0; ai < 2; ++ai)
#pragma unroll
                for (int m = 0; m < 4; ++m) { const size_t off = (size_t)(row0 + ai * 128 + m * 16) * DM + c;
                    const f32x4 x0 = *(const f32x4*)(xb + off), x1 = *(const f32x4*)(xb + off + 4);
                    *(f32x4*)(out + off) = x0 * ALPHA + g0 * acc[ai][bj][m][0]; *(f32x4*)(out + off + 4) = x1 * ALPHA + g1 * acc[ai][bj][m][1]; } }
    }
};

constexpr int S5_WLDS = 10240 + 4352 + 1024;
__device__ __forceinline__ void s5_task(const float* ub, float* ys, int row0, int L, int g, int d,
                                        const float* __restrict__ a_re, const float* __restrict__ a_im, const float* __restrict__ log_dt,
                                        const float* __restrict__ b_re, const float* __restrict__ b_im, const float* __restrict__ c_re, const float* __restrict__ c_im,
                                        const float* h0re, const float* h0im, float* fre, float* fim, LAS unsigned char* wl, int lane) {
    LAS float* BuS = (LAS float*)wl; LAS unsigned char* Xs = wl + 10240; LAS float* par = (LAS float*)(wl + 10240 + 4352);
    const int fr = lane & 15, fq = lane >> 4;
    const int pg = d * 128 + g;
    float abr, abi;
    {
        const float ar = a_re[pg * 64 + lane], ai = a_im[pg * 64 + lane], dt = __expf(log_dt[pg]);
        const float mag = __expf(dt * ar); float sn, cs; sincos_acc(dt * ai, sn, cs);
        abr = mag * cs; abi = mag * sn;
        const float den = ar * ar + ai * ai, pr = abr - 1.0f;
        const float qr = (pr * ar + abi * ai) / den, qi = (abi * ar - pr * ai) / den;
        par[lane] = qr; par[64 + lane] = qi;
    }
    LDS_WAIT();
    bf16x8 Bre[4], Bim[4];
#pragma unroll
    for (int nb = 0; nb < 4; ++nb) { const int n = 16 * nb + fr; const float qr = par[n], qi = par[64 + n];
        const float* br = b_re + ((size_t)pg * 64 + n) * 16 + 8 * (fq & 1); const float* bi = b_im + ((size_t)pg * 64 + n) * 16 + 8 * (fq & 1);
        const f32x4 r0 = *(const f32x4*)br, r1 = *(const f32x4*)(br + 4), i0 = *(const f32x4*)bi, i1 = *(const f32x4*)(bi + 4);
        const f32x4 e0 = r0 * qr - i0 * qi, e1 = r1 * qr - i1 * qi, f0 = i0 * qr + r0 * qi, f1 = i1 * qr + r1 * qi;
        u32x4 wr_, wi_; wr_.x = cvt_pk_bf16(e0[0], e0[1]); wr_.y = cvt_pk_bf16(e0[2], e0[3]); wr_.z = cvt_pk_bf16(e1[0], e1[1]); wr_.w = cvt_pk_bf16(e1[2], e1[3]);
        wi_.x = cvt_pk_bf16(f0[0], f0[1]); wi_.y = cvt_pk_bf16(f0[2], f0[3]); wi_.z = cvt_pk_bf16(f1[0], f1[1]); wi_.w = cvt_pk_bf16(f1[2], f1[3]);
        Bre[nb] = __builtin_bit_cast(bf16x8, wr_); Bim[nb] = __builtin_bit_cast(bf16x8, wi_); }
    bf16x8 Cf[4];
#pragma unroll
    for (int ks = 0; ks < 4; ++ks) { const float* cp = ((ks < 2) ? c_re : c_im) + ((size_t)pg * 16 + fr) * 64 + 32 * (ks & 1) + 8 * fq; const float sg = (ks < 2) ? 1.0f : -1.0f;
        const f32x4 v0 = *(const f32x4*)cp * sg, v1 = *(const f32x4*)(cp + 4) * sg;
        u32x4 w; w.x = cvt_pk_bf16(v0[0], v0[1]); w.y = cvt_pk_bf16(v0[2], v0[3]); w.z = cvt_pk_bf16(v1[0], v1[1]); w.w = cvt_pk_bf16(v1[2], v1[3]);
        Cf[ks] = __builtin_bit_cast(bf16x8, w); }
    float xr = 0.f, xi = 0.f;
    if (h0re) { xr = h0re[lane]; xi = h0im[lane]; }
    const int nch = L >> 4;
    const float* ucol = ub + (size_t)g * 16 + 8 * (fq & 1);
    f32x4 un0, un1;
    { const int t0 = d ? (L - 16) : 0; const float* up = ucol + (size_t)(row0 + t0 + fr) * S5W; un0 = *(const f32x4*)up; un1 = *(const f32x4*)(up + 4); }
    for (int ch = 0; ch < nch; ++ch) {
        const int t0 = d ? (L - 16 - 16 * ch) : 16 * ch;
        const f32x4 u0 = un0, u1 = un1;
        if (ch + 1 < nch) { const int t1 = d ? (t0 - 16) : (t0 + 16); const float* up = ucol + (size_t)(row0 + t1 + fr) * S5W; un0 = *(const f32x4*)up; un1 = *(const f32x4*)(up + 4); }
        float uu[8] = {u0[0], u0[1], u0[2], u0[3], u1[0], u1[1], u1[2], u1[3]};
        if (fq >= 2) {
#pragma unroll
            for (int e = 0; e < 8; ++e) uu[e] = uu[e] - bf2f(f2bf(uu[e]));
        }
        u32x4 aw; aw.x = cvt_pk_bf16(uu[0], uu[1]); aw.y = cvt_pk_bf16(uu[2], uu[3]); aw.z = cvt_pk_bf16(uu[4], uu[5]); aw.w = cvt_pk_bf16(uu[6], uu[7]);
        const bf16x8 Af = __builtin_bit_cast(bf16x8, aw);
#pragma unroll
        for (int nb = 0; nb < 4; ++nb) {
            const f32x4 z = {0.f, 0.f, 0.f, 0.f};
            const f32x4 br = __builtin_amdgcn_mfma_f32_16x16x32_bf16(Af, Bre[nb], z, 0, 0, 0);
            const f32x4 bi = __builtin_amdgcn_mfma_f32_16x16x32_bf16(Af, Bim[nb], z, 0, 0, 0);
            *(LAS f32x4*)(BuS + (16 * nb + fr) * 20 + 4 * fq) = br;
            *(LAS f32x4*)(BuS + 1280 + (16 * nb + fr) * 20 + 4 * fq) = bi;
        }
        LDS_WAIT();
#pragma unroll
        for (int jj = 0; jj < 4; ++jj) { const int j = d ? (3 - jj) : jj;
            const f32x4 vr = *(const LAS f32x4*)(BuS + lane * 20 + 4 * j), vi = *(const LAS f32x4*)(BuS + 1280 + lane * 20 + 4 * j);
#pragma unroll
            for (int ii = 0; ii < 4; ++ii) { const int i = d ? (3 - ii) : ii;
                const float nr = fmaf(abr, xr, fmaf(-abi, xi, vr[i])), ni = fmaf(abr, xi, fmaf(abi, xr, vi[i]));
                xr = nr; xi = ni;
                const int t = 4 * j + i;
                *(LAS unsigned short*)(Xs + t * 272 + lane * 2) = (unsigned short)f2bf(xr);
                *(LAS unsigned short*)(Xs + t * 272 + 128 + lane * 2) = (unsigned short)f2bf(xi); } }
        LDS_WAIT();
        f32x4 y = {0.f, 0.f, 0.f, 0.f};
#pragma unroll
        for (int ks = 0; ks < 4; ++ks) { const bf16x8 xa = *(const LAS bf16x8*)(Xs + fr * 272 + (32 * ks + 8 * fq) * 2);
            y = __builtin_amdgcn_mfma_f32_16x16x32_bf16(xa, Cf[ks], y, 0, 0, 0); }
        float* yp = ys + (size_t)(row0 + t0 + 4 * fq) * S5W + g * 16 + fr;
        yp[0] = y[0]; yp[S5W] = y[1]; yp[2 * S5W] = y[2]; yp[3 * S5W] = y[3];
        LDS_WAIT();
    }
    if (fre) { fre[lane] = xr; fim[lane] = xi; }
}

constexpr int ATT_KB = 64 * 400, ATT_VB = 128 * 144, ATT_BUF = ATT_KB + ATT_VB;
__device__ __forceinline__ void attn_unit(const bf16* Q, const bf16* KN, const bf16* KPEB, const bf16* VT, const bf16* sza, unsigned char* ab8,
                                          int qrow0, int h, int nt, int nt1, int key1, int key2, int rope_t0  ,
                                          LAS unsigned char* lds, int tid, int wave, int lane) {
    const int fr = lane & 15, fq = lane >> 4;
    bf16x8 qf[2][6];
#pragma unroll
    for (int qb = 0; qb < 2; ++qb) { const bf16* qp = Q + (size_t)(qrow0 + 32 * wave + 16 * qb + fr) * 3072 + h * 192 + 8 * fq;
#pragma unroll
        for (int ks = 0; ks < 6; ++ks) qf[qb][ks] = __builtin_bit_cast(bf16x8, *(const u32x4*)(qp + 32 * ks)); }
    if (rope_t0 >= 0) {
#pragma unroll
        for (int qb = 0; qb < 2; ++qb) { const int tq = rope_t0 + 32 * wave + 16 * qb + fr;
#pragma unroll
            for (int half = 0; half < 2; ++half) { const float pos = (float)(half == 0 ? (tq >> 6) : (tq & 63));
                u32x4 w = __builtin_bit_cast(u32x4, qf[qb][4 + half]);
                float v[8] = {bflo(w.x), bfhi(w.x), bflo(w.y), bfhi(w.y), bflo(w.z), bfhi(w.z), bflo(w.w), bfhi(w.w)};
                float o[8];
#pragma unroll
                for (int j = 0; j < 8; ++j) { const float pv = __shfl_xor(v[j], 32);
                    float sn, cs; sincos_acc(pos * rope_inv(8 * (fq & 1) + j), sn, cs);
                    o[j] = (fq < 2) ? (v[j] * cs - pv * sn) : (v[j] * cs + pv * sn); }
                w.x = cvt_pk_bf16(o[0], o[1]); w.y = cvt_pk_bf16(o[2], o[3]); w.z = cvt_pk_bf16(o[4], o[5]); w.w = cvt_pk_bf16(o[6], o[7]);
                qf[qb][4 + half] = __builtin_bit_cast(bf16x8, w); } }
    }
    f32x4 oacc[2][8];
#pragma unroll
    for (int qb = 0; qb < 2; ++qb)
#pragma unroll
        for (int db = 0; db < 8; ++db) oacc[qb][db] = (f32x4){0.f, 0.f, 0.f, 0.f};
    float mrun[2] = {-1e30f, -1e30f}, lrun[2] = {0.f, 0.f};
    const float SC = 0.07216878364870322f * 1.4426950408889634f;
    u32x4 sk0, sk1, sp, sv0, sv1;
    const int kr = tid >> 4, kc = tid & 15;
    const int pr = tid >> 3, pc = tid & 7;
    const int vr = tid >> 3, vc = tid & 7;
#define ATT_LOAD(t) do { const int key0_ = ((t) < nt1) ? key1 + 64 * (t) : key2 + 64 * ((t) - nt1); \
        sk0 = *(const u32x4*)(KN + (size_t)(key0_ + kr) * 2048 + h * 128 + 8 * kc); sk1 = *(const u32x4*)(KN + (size_t)(key0_ + kr + 32) * 2048 + h * 128 + 8 * kc); \
        sp = *(const u32x4*)(KPEB + (size_t)(key0_ + pr) * 64 + 8 * pc); \
        sv0 = *(const u32x4*)(VT + (size_t)(h * 128 + vr) * NKV + key0_ + 8 * vc); sv1 = *(const u32x4*)(VT + (size_t)(h * 128 + vr + 64) * NKV + key0_ + 8 * vc); } while (0)
#define ATT_STORE(b) do { LAS unsigned char* kb_ = lds + (b) * ATT_BUF; LAS unsigned char* vb_ = kb_ + ATT_KB; \
        *(LAS u32x4*)(kb_ + kr * 400 + kc * 16) = sk0; *(LAS u32x4*)(kb_ + (kr + 32) * 400 + kc * 16) = sk1; *(LAS u32x4*)(kb_ + pr * 400 + 256 + pc * 16) = sp; \
        *(LAS u32x4*)(vb_ + vr * 144 + vc * 16) = sv0; *(LAS u32x4*)(vb_ + (vr + 64) * 144 + vc * 16) = sv1; } while (0)
    ATT_LOAD(0); ATT_STORE(0);
    __syncthreads();
    for (int t = 0; t < nt; ++t) {
        if (t + 1 < nt) ATT_LOAD(t + 1);
        const LAS unsigned char* kb = lds + (t & 1) * ATT_BUF; const LAS unsigned char* vb = kb + ATT_KB;
        f32x4 s[2][4];
#pragma unroll
        for (int qb = 0; qb < 2; ++qb)
#pragma unroll
            for (int kb4 = 0; kb4 < 4; ++kb4) s[qb][kb4] = (f32x4){0.f, 0.f, 0.f, 0.f};
#pragma unroll
        for (int ks = 0; ks < 6; ++ks)
#pragma unroll
            for (int kb4 = 0; kb4 < 4; ++kb4) { const bf16x8 kf = *(const LAS bf16x8*)(kb + (16 * kb4 + fr) * 400 + (32 * ks + 8 * fq) * 2);
                s[0][kb4] = __builtin_amdgcn_mfma_f32_16x16x32_bf16(kf, qf[0][ks], s[0][kb4], 0, 0, 0);
                s[1][kb4] = __builtin_amdgcn_mfma_f32_16x16x32_bf16(kf, qf[1][ks], s[1][kb4], 0, 0, 0); }
        bf16x8 pf[2][2];
#pragma unroll
        for (int qb = 0; qb < 2; ++qb) {
            float mx = -1e30f;
#pragma unroll
            for (int kb4 = 0; kb4 < 4; ++kb4) { s[qb][kb4] = s[qb][kb4] * SC; mx = fmaxf(mx, fmaxf(fmaxf(s[qb][kb4][0], s[qb][kb4][1]), fmaxf(s[qb][kb4][2], s[qb][kb4][3]))); }
            mx = fmaxf(mx, __shfl_xor(mx, 16)); mx = fmaxf(mx, __shfl_xor(mx, 32));
            const float mnew = fmaxf(mrun[qb], mx), alpha = exp2f(mrun[qb] - mnew); mrun[qb] = mnew;
            float ps = 0.f;
#pragma unroll
            for (int kb4 = 0; kb4 < 4; ++kb4) {
#pragma unroll
                for (int i = 0; i < 4; ++i) { const float p = exp2f(s[qb][kb4][i] - mnew); s[qb][kb4][i] = p; ps += p; } }
            lrun[qb] = lrun[qb] * alpha + ps;
#pragma unroll
            for (int db = 0; db < 8; ++db) oacc[qb][db] = oacc[qb][db] * alpha;
#pragma unroll
            for (int kk = 0; kk < 2; ++kk) { u32x4 w; w.x = cvt_pk_bf16(s[qb][2 * kk][0], s[qb][2 * kk][1]); w.y = cvt_pk_bf16(s[qb][2 * kk][2], s[qb][2 * kk][3]);
                w.z = cvt_pk_bf16(s[qb][2 * kk + 1][0], s[qb][2 * kk + 1][1]); w.w = cvt_pk_bf16(s[qb][2 * kk + 1][2], s[qb][2 * kk + 1][3]);
                pf[qb][kk] = __builtin_bit_cast(bf16x8, w); }
        }
#pragma unroll
        for (int db = 0; db < 8; ++db)
#pragma unroll
            for (int kk = 0; kk < 2; ++kk) { const LAS unsigned char* vp = vb + (16 * db + fr) * 144 + (32 * kk + 4 * fq) * 2;
                const u32x2 lo = *(const LAS u32x2*)vp, hi = *(const LAS u32x2*)(vp + 32);
                u32x4 w; w.x = lo.x; w.y = lo.y; w.z = hi.x; w.w = hi.y; const bf16x8 vf = __builtin_bit_cast(bf16x8, w);
                oacc[0][db] = __builtin_amdgcn_mfma_f32_16x16x32_bf16(vf, pf[0][kk], oacc[0][db], 0, 0, 0);
                oacc[1][db] = __builtin_amdgcn_mfma_f32_16x16x32_bf16(vf, pf[1][kk], oacc[1][db], 0, 0, 0); }
        if (t + 1 < nt) ATT_STORE((t + 1) & 1);
        __syncthreads();
    }
#undef ATT_LOAD
#undef ATT_STORE
#pragma unroll
    for (int qb = 0; qb < 2; ++qb) { float l = lrun[qb]; l += __shfl_xor(l, 16); l += __shfl_xor(l, 32); const float inv = 1.0f / l;
        const size_t row = (size_t)(qrow0 + 32 * wave + 16 * qb + fr);
#pragma unroll
        for (int db = 0; db < 8; ++db) { const int dcol = h * 128 + 16 * db + 4 * fq; const u32x2 zv = *(const u32x2*)(sza + row * MLAW + dcol); const f32x4 o = oacc[qb][db] * inv;
            *(unsigned*)(ab8 + row * DM + dcol) = pk_fp8x4(o[0] * bflo(zv.x) * S_AB, o[1] * bfhi(zv.x) * S_AB, o[2] * bflo(zv.y) * S_AB, o[3] * bfhi(zv.y) * S_AB); } }
}

#define XB_TMO      128
#define XB_XCNT(j)  (256  + 64 * (j))
#define XB_XSUB(j)  (1280 + 64 * (j))
#define XB_XGEN(j)  (2304 + 64 * (j))
#define XB_TOP      3328
#define XB_TOPGEN   3392
#define XCD_BAR_WORDS 3456
#define XB_SPIN_CAP (1u << 18)

__device__ __forceinline__ unsigned xb_ld(unsigned* p)              { return __hip_atomic_load(p, __ATOMIC_RELAXED, __HIP_MEMORY_SCOPE_AGENT); }
__device__ __forceinline__ unsigned xb_add(unsigned* p, unsigned v) { return __hip_atomic_fetch_add(p, v, __ATOMIC_RELAXED, __HIP_MEMORY_SCOPE_AGENT); }
__device__ __forceinline__ unsigned xb_xcc_id() { return (unsigned)__builtin_amdgcn_s_getreg((3 << 11) | 20) & 0xFu; }
#define XB_SPIN(cond, bar) do { unsigned _sp = 0; while (cond) { __builtin_amdgcn_s_sleep(1); \
    if ((++_sp & 255u) == 0u) { if (xb_ld(&(bar)[XB_TMO])) break; if (_sp > XB_SPIN_CAP) { atomicAdd(&(bar)[XB_TMO], 1u); break; } } } } while (0)

struct XcdBarrier {
    unsigned* bar; unsigned x;
    volatile LAS unsigned* st;
};

__device__ __forceinline__ XcdBarrier xcd_barrier_post(unsigned* bar, volatile LAS unsigned* st) {
    XcdBarrier b; b.bar = bar; b.x = xb_xcc_id(); b.st = st;
    if (threadIdx.x == 0) (void)xb_add(&bar[XB_XCNT(b.x)], 1u);
    return b;
}
__device__ __forceinline__ void xcd_barrier_complete(unsigned* bar, unsigned x, unsigned& nloc, unsigned& nx) {
    const unsigned G = gridDim.x * gridDim.y * gridDim.z;
    unsigned sum, cnt, mine, sp = 0u;
    for (;;) {
        sum = 0u; cnt = 0u; mine = 0u;
#pragma unroll
        for (unsigned j = 0; j < 16; ++j) { const unsigned c = xb_ld(&bar[XB_XCNT(j)]); sum += c; cnt += (c > 0u) ? 1u : 0u; mine = (j == x) ? c : mine; }
        if (sum == G) break;
        __builtin_amdgcn_s_sleep(1);
        if ((++sp & 255u) == 0u) { if (xb_ld(&bar[XB_TMO])) break; if (sp > XB_SPIN_CAP) { atomicAdd(&bar[XB_TMO], 1u); break; } }
    }
    nloc = mine > 0u ? mine : 1u; nx = cnt > 0u ? cnt : 1u;
}

__device__ __forceinline__ void xcd_barrier(const XcdBarrier& b) {
    asm volatile("s_waitcnt vmcnt(0)" ::: "memory");
    __syncthreads();
    if (threadIdx.x == 0) {
        unsigned* bar = b.bar;
        __builtin_amdgcn_s_waitcnt(0);
        unsigned nloc = b.st[0], nx = b.st[1];
        if (nloc == 0u) { xcd_barrier_complete(bar, b.x, nloc, nx); b.st[0] = nloc; b.st[1] = nx; }
        const unsigned old = xb_add(&bar[XB_XSUB(b.x)], 1u);
        const unsigned gen = old / nloc;
        if (old + 1u == (gen + 1u) * nloc) {
            __builtin_amdgcn_fence(__ATOMIC_RELEASE, "agent");
            asm volatile("s_waitcnt vmcnt(0)" ::: "memory");
            const unsigned og = xb_add(&bar[XB_TOP], 1u);
            const unsigned tg = og / nx;
            if (og + 1u == (tg + 1u) * nx) xb_add(&bar[XB_TOPGEN], 1u);
            else XB_SPIN(xb_ld(&bar[XB_TOPGEN]) == tg, bar);
            __builtin_amdgcn_fence(__ATOMIC_ACQUIRE, "agent");
            xb_add(&bar[XB_XGEN(b.x)], 1u);
            asm volatile("s_waitcnt vmcnt(0)" ::: "memory");
        } else {
            XB_SPIN(xb_ld(&bar[XB_XGEN(b.x)]) == gen, bar);
            __builtin_amdgcn_fence(__ATOMIC_ACQUIRE, "agent");
            asm volatile("s_waitcnt vmcnt(0)" ::: "memory");
        }
    }
    __syncthreads();
}

struct ListOrder {
    int n, pm0, pn0, pm1, pn1, pm2, pn2;
    __device__ __forceinline__ bool next(int i, pg8::Unit& u) const { if (i >= n) return false; u.pm = (i == 0) ? pm0 : ((i == 1) ? pm1 : pm2); u.pn = (i == 0) ? pn0 : ((i == 1) ? pn1 : pn2); return true; }
    __device__ __forceinline__ void a_ready(const pg8::Unit&) const {}
    __device__ __forceinline__ void done(const pg8::Unit&) const {}
};
struct Params { const float* in[30]; float* out; unsigned char* ws; };

#define x_prompt (P.in[0])
#define x_sample (P.in[1])
#define cache_ckv (P.in[2])
#define cache_kpe (P.in[3])
#define st_re (P.in[4])
#define st_im (P.in[5])
#define c_in (P.in[6])
#define c_ctx (P.in[7])
#define w_ada (P.in[8])
#define b_ada (P.in[9])
#define w_in (P.in[10])
#define g_qn (P.in[11])
#define w_uq (P.in[12])
#define g_kvn (P.in[13])
#define w_ukv (P.in[14])
#define s5_a_re (P.in[15])
#define s5_a_im (P.in[16])
#define s5_log_dt (P.in[17])
#define s5_b_re (P.in[18])
#define s5_b_im (P.in[19])
#define s5_c_re (P.in[20])
#define s5_c_im (P.in[21])
#define s5_d (P.in[22])
#define w_glu (P.in[23])
#define b_glu (P.in[24])
#define w_pa (P.in[25])
#define w_pb (P.in[26])
#define w_o (P.in[27])
#define ln_g (P.in[28])
#define ln_b (P.in[29])
#define out (P.out)
#define modp ((float*)(P.ws + WS_MODP))
#define gatev ((float*)(P.ws + WS_MOD))
#define WIN8 ((unsigned char*)(P.ws + WS_WIN8))
#define WINB ((bf16*)(P.ws + WS_WINB))
#define WUQ8 ((unsigned char*)(P.ws + WS_WUQ8))
#define WK8 ((unsigned char*)(P.ws + WS_WK8))
#define WV8 ((unsigned char*)(P.ws + WS_WV8))
#define WGLU8 ((unsigned char*)(P.ws + WS_WGLU8))
#define WPAB8 ((unsigned char*)(P.ws + WS_WPAB8))
#define WO8 ((unsigned char*)(P.ws + WS_WO8))
#define H8 ((unsigned char*)(P.ws + WS_H8))
#define H ((bf16*)(P.ws + WS_H))
#define CQ ((float*)(P.ws + WS_CQ))
#define CKVR ((float*)(P.ws + WS_CKVR))
#define KPE ((float*)(P.ws + WS_KPE))
#define UB ((float*)(P.ws + WS_UB))
#define SZA ((bf16*)(P.ws + WS_SZA))
#define SZB ((bf16*)(P.ws + WS_SZB))
#define SGA ((bf16*)(P.ws + WS_SGA))
#define SGB ((bf16*)(P.ws + WS_SGB))
#define CQN8 ((unsigned char*)(P.ws + WS_CQN8))
#define CKV8 ((unsigned char*)(P.ws + WS_CKV8))
#define KPEB ((bf16*)(P.ws + WS_KPEB))
#define Q ((bf16*)(P.ws + WS_Q))
#define KN ((bf16*)(P.ws + WS_KN))
#define VT ((bf16*)(P.ws + WS_VT))
#define YS5 ((float*)(P.ws + WS_YS5))
#define Y5 ((bf16*)(P.ws + WS_Y5))
#define Y58 ((unsigned char*)(P.ws + WS_Y58))
#define AB8 ((unsigned char*)(P.ws + WS_AB8))
#define MG8 ((unsigned char*)(P.ws + WS_MG8))
__global__ void __launch_bounds__(NTHR, 2) hybrid_fwd(Params P) {
    extern __shared__ __attribute__((aligned(16))) unsigned char lds_raw[];
    LAS unsigned char* lds = (LAS unsigned char*)lds_raw;
    cg::grid_group grid = cg::this_grid();
    const int tid = threadIdx.x, lane = tid & 63, wave = __builtin_amdgcn_readfirstlane(tid >> 6);
    const int wg = blockIdx.x, G = gridDim.x;
    const int gw = wg * NWAVES + wave, NGW = G * NWAVES;
    volatile LAS unsigned* bst = (volatile LAS unsigned*)(lds + LDS_BYTES - 64);
    if (tid < 16) bst[tid] = 0u;
    __syncthreads();
    const XcdBarrier xbar = xcd_barrier_post((unsigned*)(P.ws + WS_CTL) + 1024, bst);
#define GRID_BAR() xcd_barrier(xbar)

    if constexpr ((PHASE_MASK >> 0) & 1)
    {
        LAS float* scr = (LAS float*)(lds + wave * 16640);
        constexpr int I_IN = 64 * 249, I_UQ = 16 * 48, I_UKV = 8 * 64, I_GLU = 32 * 32, I_PA = 32 * 64, I_PB = 32 * 64, I_O = 64 * 64;
        constexpr int NITEMS = I_IN + I_UQ + I_UKV + I_GLU + I_PA + I_PB + I_O;
        for (int it = gw; it < NITEMS; it += NGW) {
            int r = it;
            if (r < I_IN) { const int kb = r / 249, nb = r % 249, n0 = 64 * nb;
                int dr;
                if (n0 < 1024) dr = 2816 + n0; else if (n0 < 1536) dr = n0 - 1024; else if (n0 < 1600) dr = 512 + (n0 - 1536); else if (n0 < 3648) dr = 3840 + (n0 - 1600);
                else if (n0 < 5696) dr = 768 + (n0 - 3648); else if (n0 < 7744) dr = 5888 + (n0 - 5696); else if (n0 < 11840) dr = 7936 + (n0 - 7744); else dr = 12032 + (n0 - 11840);
                p0_tile(w_in, INC, 64 * kb, n0, WIN8, (dr < 2816) ? WINB : nullptr, S_WIN, DM, dr, 0, scr, lane); continue; } r -= I_IN;
            if (r < I_UQ) { const int kb = r / 48, nb = r % 48; p0_tile(w_uq, 3072, 64 * kb, 64 * nb, WUQ8, nullptr, S_WUQ, QL, 64 * nb, 0, scr, lane); continue; } r -= I_UQ;
            if (r < I_UKV) { const int kb = r / 64, nb = r % 64, hh = nb >> 2, jj = nb & 3;
                p0_tile(w_ukv, 4096, 64 * kb, 64 * nb, (jj < 2) ? WK8 : WV8, nullptr, S_WKV, KVL, hh * 128 + (jj & 1) * 64, 0, scr, lane); continue; } r -= I_UKV;
            if (r < I_GLU) { const int kb = r / 32, nb = r % 32; p0_tile(w_glu, S5W, 64 * kb, 64 * nb, WGLU8, nullptr, S_WGLU, S5W, 64 * nb, 0, scr, lane); continue; } r -= I_GLU;
            if (r < I_PA) { const int kb = r / 64, nb = r % 64; p0_tile(w_pa, DM, 64 * kb, 64 * nb, WPAB8, nullptr, S_WP, DM, 64 * nb, 0, scr, lane); continue; } r -= I_PA;
            if (r < I_PB) { const int kb = r / 64, nb = r % 64; p0_tile(w_pb, DM, 64 * kb, 64 * nb, WPAB8, nullptr, S_WP, DM, 64 * nb, MLAW, scr, lane); continue; } r -= I_PB;
            { const int kb = r / 64, nb = r % 64; p0_tile(w_o, DM, 64 * kb, 64 * nb, WO8, nullptr, S_WO, DM, 64 * nb, 0, scr, lane); }
        }
        for (int i = wg * NTHR + tid; i < (1024 * KVL) / 4; i += G * NTHR) { const f32x4 v = *(const f32x4*)(cache_ckv + 4 * (size_t)i);
            *(unsigned*)(CKV8 + (size_t)MT * KVL + 4 * (size_t)i) = pk_fp8x4(v[0], v[1], v[2], v[3]); }
        for (int i = wg * NTHR + tid; i < (1024 * RD) / 4; i += G * NTHR) { const f32x4 v = *(const f32x4*)(cache_kpe + 4 * (size_t)i);
            u32x2 w; w.x = cvt_pk_bf16(v[0], v[1]); w.y = cvt_pk_bf16(v[2], v[3]); *(u32x2*)(KPEB + (size_t)MT * RD + 4 * (size_t)i) = w; }
        __syncthreads();
        if (wg < 240) {
            const int slab = wg % 48, kc = wg / 48, k0 = (kc * 4096) / 5, k1 = ((kc + 1) * 4096) / 5;
            f32x4 a0 = {0.f, 0.f, 0.f, 0.f}, a1 = a0, a2 = a0;
            const float* wp = w_ada + slab * 256 + 4 * lane;
#pragma unroll 4
            for (int k = k0 + wave; k < k1; k += NWAVES) {
                const f32x4 w = *(const f32x4*)(wp + (size_t)k * 12288);
                const float s0 = siluf_(c_ctx[k]), s1 = siluf_(c_in[k]), s2 = siluf_(c_in[DM + k]);
                a0 += w * s0; a1 += w * s1; a2 += w * s2;
            }
            LAS f32x4* red = (LAS f32x4*)lds;
            red[(wave * 3 + 0) * 64 + lane] = a0; red[(wave * 3 + 1) * 64 + lane] = a1; red[(wave * 3 + 2) * 64 + lane] = a2;
            __syncthreads();
            if (tid < 192) { const int cnd = tid >> 6, l = tid & 63; f32x4 s = red[cnd * 64 + l];
#pragma unroll
                for (int w = 1; w < 8; ++w) s += red[(w * 3 + cnd) * 64 + l];
                *(f32x4*)(modp + ((size_t)kc * 3 + cnd) * 12288 + slab * 256 + 4 * l) = s; }
        }
    }
    grid.sync();

    if constexpr ((PHASE_MASK >> 1) & 1)
    {
        { const int i = wg * NTHR + tid; if (i < 3 * DM) { const int cnd = i / DM, col = i % DM; float s = b_ada[2 * DM + col];
#pragma unroll
                for (int kc = 0; kc < 5; ++kc) s += modp[((size_t)kc * 3 + cnd) * 12288 + 2 * DM + col];
                gatev[i] = s; } }
        LAS float* sh = (LAS float*)lds; LAS float* sc1 = sh + DM;
        int cur_c = -1;
        for (int u = wg; u < 768; u += G) {
            const int cnd = u < 512 ? 0 : (u < 640 ? 1 : 2);
            if (cnd != cur_c) {
                __syncthreads();
                for (int col = tid; col < DM; col += NTHR) { float s = b_ada[col], t = b_ada[DM + col];
#pragma unroll
                    for (int kc = 0; kc < 5; ++kc) { s += modp[((size_t)kc * 3 + cnd) * 12288 + col]; t += modp[((size_t)kc * 3 + cnd) * 12288 + DM + col]; }
                    sh[col] = s; sc1[col] = 1.0f + t; }
                __syncthreads();
                cur_c = cnd;
            }
            const int row = 8 * u + wave;
            const float* xr = (row < NP) ? x_prompt + (size_t)row * DM : x_sample + (size_t)(row - NP) * DM;
            f32x4 v[16]; float s = 0.f;
#pragma unroll
            for (int j = 0; j < 16; ++j) { v[j] = *(const f32x4*)(xr + 4 * lane + 256 * j); s += (v[j][0] + v[j][1]) + (v[j][2] + v[j][3]); }
            const float mean = wave_sum(s) * (1.0f / DM); float s2 = 0.f;
#pragma unroll
            for (int j = 0; j < 16; ++j) { v[j] = v[j] - mean; s2 += (v[j][0] * v[j][0] + v[j][1] * v[j][1]) + (v[j][2] * v[j][2] + v[j][3] * v[j][3]); }
            const float rstd = 1.0f / sqrtf(wave_sum(s2) * (1.0f / DM) + LN_EPS);
            unsigned char* h8 = H8 + (size_t)row * DM; bf16* hr = H + (size_t)row * DM;
#pragma unroll
            for (int j = 0; j < 16; ++j) { const int col = 4 * lane + 256 * j; const f32x4 a = *(const LAS f32x4*)(sc1 + col), b = *(const LAS f32x4*)(sh + col);
                const f32x4 o = v[j] * rstd * a + b; *(unsigned*)(h8 + col) = pk_fp8x4(o[0], o[1], o[2], o[3]);
                if (row < NP) { u32x2 w; w.x = cvt_pk_bf16(o[0], o[1]); w.y = cvt_pk_bf16(o[2], o[3]); *(u32x2*)(hr + col) = w; } }
        }
    }
    GRID_BAR();

    if constexpr ((PHASE_MASK >> 2) & 1)
    {
        { pg8::Gemm g{(const bf16*)H8, (const bf16*)(WIN8 + (size_t)2816 * DM), MT, INP - 2816, DM / 2}; pg8::StaticOrder S; S.init(MT, INP - 2816, G, wg);
          EpiIn E{CQ, CKVR, KPE, UB, SZA, SZB, SGA, SGB, 0, 11, 1.0f / S_WIN};
          pg8::gemm_phase<EpiIn, pg8::StaticOrder, true, true, true>(lds, g, S, E); }
        __syncthreads();
        { pg8::Gemm g{(const bf16*)(H8 + (size_t)NP * DM), (const bf16*)WIN8, NS, 2816, DM / 2}; pg8::StaticOrder S; S.init(NS, 2816, G, (wg + 32) % G);
          EpiIn E{CQ, CKVR, KPE, UB, SZA, SZB, SGA, SGB, 16, 0, 1.0f / S_WIN};
          pg8::gemm_phase<EpiIn, pg8::StaticOrder, true, true, true>(lds, g, S, E); }
        __syncthreads();
        { pg8::Gemm g{H, WINB, NP, 2816, DM}; pg8::StaticOrder S; S.init(NP, 2816, G, (wg + 200) % G);
          EpiIn E{CQ, CKVR, KPE, UB, SZA, SZB, SGA, SGB, 0, 0, 1.0f};
          pg8::gemm_phase<EpiIn, pg8::StaticOrder, true, true, false>(lds, g, S, E); }
    }
    GRID_BAR();

    if constexpr ((PHASE_MASK >> 3) & 1)
    {
        for (int row = gw; row < MT; row += NGW) {
            {
                f32x4 v[4]; float s = 0.f;
#pragma unroll
                for (int j = 0; j < 4; ++j) { v[j] = *(const f32x4*)(CQ + (size_t)row * QL + 4 * lane + 256 * j); s += (v[j][0] * v[j][0] + v[j][1] * v[j][1]) + (v[j][2] * v[j][2] + v[j][3] * v[j][3]); }
                const float rs = 1.0f / sqrtf(wave_sum(s) * (1.0f / QL) + LN_EPS);
#pragma unroll
                for (int j = 0; j < 4; ++j) { const int col = 4 * lane + 256 * j; const f32x4 gq = *(const f32x4*)(g_qn + col); const f32x4 o = v[j] * rs * gq;
                    *(unsigned*)(CQN8 + (size_t)row * QL + col) = pk_fp8x4(o[0], o[1], o[2], o[3]); }
            }
            {
                f32x4 v[2]; float s = 0.f;
#pragma unroll
                for (int j = 0; j < 2; ++j) { v[j] = *(const f32x4*)(CKVR + (size_t)row * KVL + 4 * lane + 256 * j); s += (v[j][0] * v[j][0] + v[j][1] * v[j][1]) + (v[j][2] * v[j][2] + v[j][3] * v[j][3]); }
                const float rs = 1.0f / sqrtf(wave_sum(s) * (1.0f / KVL) + LN_EPS);
#pragma unroll
                for (int j = 0; j < 2; ++j) { const int col = 4 * lane + 256 * j; const f32x4 gk = *(const f32x4*)(g_kvn + col); const f32x4 o = v[j] * rs * gk;
                    *(unsigned*)(CKV8 + (size_t)row * KVL + col) = pk_fp8x4(o[0], o[1], o[2], o[3]);
                    if (row < NP) *(f32x4*)(out + O_CKV + (size_t)row * KVL + col) = o; }
            }
            {
                const float kv = KPE[(size_t)row * RD + lane]; float o = kv;
                if (row < NP) out[O_KPE + (size_t)row * RD + lane] = kv;
                else { const int t = (row - NP) & 1023; const float pos = (float)((lane < 32) ? (t >> 6) : (t & 63)); const float pv = __shfl_xor(kv, 16);
                    float sn, cs; sincos_acc(pos * rope_inv(lane & 15), sn, cs);
                    o = ((lane & 16) == 0) ? (kv * cs - pv * sn) : (kv * cs + pv * sn); }
                KPEB[(size_t)row * RD + lane] = (bf16)f2bf(o);
            }
        }
        LAS unsigned char* wl = lds + wave * S5_WLDS;
        if (wave < 2) {
            const int id = wg * 2 + wave;
            if (id < 512) { const int b = id >> 8, g = (id & 255) >> 1, d = id & 1;
                s5_task(UB, YS5 + (size_t)d * MT * S5W, NP + b * 1024, 1024, g, d, s5_a_re, s5_a_im, s5_log_dt, s5_b_re, s5_b_im, s5_c_re, s5_c_im,
                        st_re + ((size_t)(b * 2 + d) * 128 + g) * 64, st_im + ((size_t)(b * 2 + d) * 128 + g) * 64, nullptr, nullptr, wl, lane); }
        } else {
            for (int j = 0; j < 3; ++j) { const int pid = wg * 6 + (wave - 2) + 1536 * j;
                if (pid < 4096) { const int d = pid & 1, pgi = pid >> 1, b = pgi >> 7, g = pgi & 127;
                    s5_task(UB, YS5 + (size_t)d * MT * S5W, b * 256, 256, g, d, s5_a_re, s5_a_im, s5_log_dt, s5_b_re, s5_b_im, s5_c_re, s5_c_im,
                            nullptr, nullptr, out + O_SRE + ((size_t)(b * 2 + d) * 128 + g) * 64, out + O_SIM + ((size_t)(b * 2 + d) * 128 + g) * 64, wl, lane); } }
        }
        VM_WAIT();
        __syncthreads();
        for (int pi = 0; pi < 10; ++pi) {
            int row0, L, g;
            if (pi == 0) { if (wg >= 256) continue; row0 = NP + (wg >> 7) * 1024; L = 1024; g = wg & 127; }
            else { const int pp = (pi - 1) % 3, j = (pi - 1) / 3; const int pgi = wg * 3 + pp + 768 * j; if (pgi >= 2048) continue; row0 = (pgi >> 7) * 256; L = 256; g = pgi & 127; }
            for (int it = tid; it < L * 4; it += NTHR) { const int t = it >> 2, q4 = it & 3; const size_t off = (size_t)(row0 + t) * S5W + g * 16 + 4 * q4;
                const f32x4 u = *(const f32x4*)(UB + off), y0 = *(const f32x4*)(YS5 + off), y1 = *(const f32x4*)(YS5 + (size_t)MT * S5W + off), dk = *(const f32x4*)(s5_d + g * 16 + 4 * q4);
                const f32x4 y = dk * u + y0 + y1;
                const float g0 = gelu_tanh(y[0]), g1 = gelu_tanh(y[1]), g2 = gelu_tanh(y[2]), g3 = gelu_tanh(y[3]);
                u32x2 w; w.x = cvt_pk_bf16(g0, g1); w.y = cvt_pk_bf16(g2, g3); *(u32x2*)(Y5 + off) = w;
                *(unsigned*)(Y58 + off) = pk_fp8x4(g0 * S_Y5, g1 * S_Y5, g2 * S_Y5, g3 * S_Y5); }
        }
    }
    GRID_BAR();

    if constexpr ((PHASE_MASK >> 4) & 1)
    {
        { ListOrder S{}; if (wg < 192) { S.n = 1; S.pm0 = wg % 24; S.pn0 = wg / 24; }
          pg8::Gemm g{(const bf16*)Y58, (const bf16*)WGLU8, MT, S5W, S5W / 2}; EpiGlu E{Y5, SZB, b_glu, AB8, 1.0f / (S_Y5 * S_WGLU)};
          pg8::gemm_phase<EpiGlu, ListOrder, true, true, true>(lds, g, S, E); }
        __syncthreads();
        { ListOrder S{}; if (wg >= 192) { const int t0 = 2 * (wg - 192); S.n = 2; S.pm0 = t0 % 24; S.pn0 = t0 / 24; S.pm1 = (t0 + 1) % 24; S.pn1 = (t0 + 1) / 24; }
          else if (wg < 160) { const int t0 = 128 + wg; S.n = 1; S.pm0 = t0 % 24; S.pn0 = t0 / 24; }
          pg8::Gemm g{(const bf16*)CQN8, (const bf16*)WUQ8, MT, 3072, QL / 2}; EpiStore E{Q, 3072, 1.0f / S_WUQ};
          pg8::gemm_phase<EpiStore, ListOrder, true, true, true>(lds, g, S, E); }
        __syncthreads();
        const int id0 = (wg >= 160) ? 3 * (wg - 160) : 288 + wg, nid = (wg >= 160) ? 3 : 1;
        { ListOrder S{}; int n = 0;
          for (int k = 0; k < nid; ++k) { const int id = id0 + k; if (id < 224) { const int pm = id % 28, pn = id / 28; if (n == 0) { S.pm0 = pm; S.pn0 = pn; } else if (n == 1) { S.pm1 = pm; S.pn1 = pn; } else { S.pm2 = pm; S.pn2 = pn; } ++n; } }
          S.n = n;
          pg8::Gemm g{(const bf16*)CKV8, (const bf16*)WK8, NKV, 2048, KVL / 2}; EpiStore E{KN, 2048, 1.0f / S_WKV};
          pg8::gemm_phase<EpiStore, ListOrder, true, true, true>(lds, g, S, E); }
        __syncthreads();
        { ListOrder S{}; int n = 0;
          for (int k = 0; k < nid; ++k) { const int id = id0 + k - 224; if (id >= 0) { const int pm = id % 8, pn = id / 8; if (n == 0) { S.pm0 = pm; S.pn0 = pn; } else if (n == 1) { S.pm1 = pm; S.pn1 = pn; } else { S.pm2 = pm; S.pn2 = pn; } ++n; } }
          S.n = n;
          pg8::Gemm g{(const bf16*)WV8, (const bf16*)CKV8, 2048, NKV, KVL / 2}; EpiStore E{VT, NKV, 1.0f / S_WKV};
          pg8::gemm_phase<EpiStore, ListOrder, true, true, true>(lds, g, S, E); }
    }
    GRID_BAR();

    if constexpr ((PHASE_MASK >> 5) & 1)
    {
        for (int rnd = 0; rnd < 2; ++rnd) {
            int qrow0, h, nt, nt1, key1, key2, rope_t0;
            if (wg < 128) { if (rnd) break; const int b = wg >> 6, hq = wg & 63; h = hq >> 2; const int qb = hq & 3;
                qrow0 = NP + b * 1024 + qb * 256; nt = 24; nt1 = 16; key1 = NP + b * 1024; key2 = MT + b * 512; rope_t0 = qb * 256; }
            else { const int uid = (wg - 128) * 2 + rnd; if (uid >= 256) break; const int b = uid >> 4; h = uid & 15;
                qrow0 = b * 256; nt = 4; nt1 = 4; key1 = b * 256; key2 = 0; rope_t0 = -1; }
            attn_unit(Q, KN, KPEB, VT, SZA, AB8, qrow0, h, nt, nt1, key1, key2, rope_t0, lds, tid, wave, lane);
            __syncthreads();
        }
    }
    GRID_BAR();

    if constexpr ((PHASE_MASK >> 6) & 1)
    {
        const int x = wg & 7, i = wg >> 3, pl = i & 3, cl = i >> 2;
        const pg8::Gemm g6{(const bf16*)AB8, (const bf16*)WPAB8, MT, DM, DM / 2}; const EpiMerge E6{SGA, SGB, MG8, S_MG / (S_AB * S_WP)};
        const pg8::Gemm g7{(const bf16*)MG8, (const bf16*)WO8, MT, DM, DM / 2}; const EpiOut E7{x_prompt, x_sample, gatev, out, 1.0f / (S_MG * S_WO)};
        { ListOrder S{}; S.n = 1; S.pm0 = 4 * (x >> 1) + pl; S.pn0 = 8 * (x & 1) + cl;
          pg8::gemm_phase<EpiMerge, ListOrder, true, true, true>(lds, g6, S, E6); }
        GRID_BAR();
        if (x < 4) { ListOrder S{}; S.n = 1; S.pm0 = 16 + 4 * (x >> 1) + pl; S.pn0 = 8 * (x & 1) + cl;
          pg8::gemm_phase<EpiMerge, ListOrder, true, true, true>(lds, g6, S, E6); }
        else { const int y = x - 4; ListOrder S{}; S.n = 1; S.pm0 = 4 * (y >> 1) + pl; S.pn0 = 8 * (y & 1) + cl;
          pg8::gemm_phase<EpiOut, ListOrder, true, true, true>(lds, g7, S, E7); }
        GRID_BAR();
        { ListOrder S{}; S.n = 1; S.pm0 = 8 + 4 * (x >> 1) + pl; S.pn0 = 8 * (x & 1) + cl;
          pg8::gemm_phase<EpiOut, ListOrder, true, true, true>(lds, g7, S, E7); }
    }
    GRID_BAR();

    if constexpr ((PHASE_MASK >> 8) & 1)
    for (int row = gw; row < MT; row += NGW) {
        float* zr = out + (size_t)row * DM;
        f32x4 v[16]; float s = 0.f;
#pragma unroll
        for (int j = 0; j < 16; ++j) { v[j] = *(const f32x4*)(zr + 4 * lane + 256 * j); s += (v[j][0] + v[j][1]) + (v[j][2] + v[j][3]); }
        const float mean = wave_sum(s) * (1.0f / DM); float s2 = 0.f;
#pragma unroll
        for (int j = 0; j < 16; ++j) { v[j] = v[j] - mean; s2 += (v[j][0] * v[j][0] + v[j][1] * v[j][1]) + (v[j][2] * v[j][2] + v[j][3] * v[j][3]); }
        const float rstd = 1.0f / sqrtf(wave_sum(s2) * (1.0f / DM) + LN_EPS);
#pragma unroll
        for (int j = 0; j < 16; ++j) { const int col = 4 * lane + 256 * j; const f32x4 gg = *(const f32x4*)(ln_g + col), bb = *(const f32x4*)(ln_b + col);
            *(f32x4*)(zr + col) = v[j] * rstd * gg + bb; }
    }
}

#undef x_prompt
#undef x_sample
#undef cache_ckv
#undef cache_kpe
#undef st_re
#undef st_im
#undef c_in
#undef c_ctx
#undef w_ada
#undef b_ada
#undef w_in
#undef g_qn
#undef w_uq
#undef g_kvn
#undef w_ukv
#undef s5_a_re
#undef s5_a_im
#undef s5_log_dt
#undef s5_b_re
#undef s5_b_im
#undef s5_c_re
#undef s5_c_im
#undef s5_d
#undef w_glu
#undef b_glu
#undef w_pa
#undef w_pb
#undef w_o
#undef ln_g
#undef ln_b
#undef out
#undef modp
#undef gatev
#undef WIN8
#undef WINB
#undef WUQ8
#undef WK8
#undef WV8
#undef WGLU8
#undef WPAB8
#undef WO8
#undef H8
#undef H
#undef CQ
#undef CKVR
#undef KPE
#undef UB
#undef SZA
#undef SZB
#undef SGA
#undef SGB
#undef CQN8
#undef CKV8
#undef KPEB
#undef Q
#undef KN
#undef VT
#undef YS5
#undef Y5
#undef Y58
#undef AB8
#undef MG8
extern "C" void kernel_launch(void* const* d_in, const int* in_sizes, int n_in, void* d_out, int out_size, void* d_ws, size_t ws_size, hipStream_t stream) {
    static int grid = 0;
    if (grid == 0) {
        if (n_in != 30 || ws_size < WS_END) { fprintf(stderr, "kernel_launch: need 30 inputs and %zu bytes of workspace; got %d, %zu\n", (size_t)WS_END, n_in, ws_size); grid = -1; return; }
        int dev = 0, cus = 0, per_cu = 0;
        hipGetDevice(&dev); hipDeviceGetAttribute(&cus, hipDeviceAttributeMultiprocessorCount, dev);
        if (hipFuncSetAttribute((const void*)hybrid_fwd, hipFuncAttributeMaxDynamicSharedMemorySize, LDS_BYTES) != hipSuccess) { fprintf(stderr, "kernel_launch: hipFuncSetAttribute failed\n"); grid = -1; return; }
        hipOccupancyMaxActiveBlocksPerMultiprocessor(&per_cu, (const void*)hybrid_fwd, NTHR, LDS_BYTES);
        (void)hipGetLastError();
        if (per_cu < 1) { fprintf(stderr, "kernel_launch: occupancy query says %d blocks per CU\n", per_cu); per_cu = 1; }
        grid = cus;
        if (grid != 256) { fprintf(stderr, "kernel_launch: built for a 256-CU device (got %d)\n", cus); grid = -1; return; }
    }
    if (grid < 0) return;
    if (hipMemsetAsync((char*)d_ws + WS_CTL, 0, CTL_ZERO_BYTES, stream) != hipSuccess) { fprintf(stderr, "kernel_launch: memset failed\n"); return; }
    Params p{};
    for (int i = 0; i < 30; ++i) p.in[i] = (const float*)d_in[i];
    p.out = (float*)d_out; p.ws = (unsigned char*)d_ws;
    void* args[] = {&p};
    hipError_t e = hipLaunchCooperativeKernel((const void*)hybrid_fwd, dim3(grid), dim3(NTHR), args, LDS_BYTES, stream);
    if (e != hipSuccess) fprintf(stderr, "cooperative launch failed: %s (grid %d)\n", hipGetErrorString(e), grid);
}
```

```cpp
#include <hip/hip_runtime.h>
#include <hip/hip_cooperative_groups.h>
#include <cstdio>
#include <cstdint>
namespace cg = cooperative_groups;
namespace pg8 {
#define PG8_LAS __attribute__((address_space(3)))
typedef unsigned short bf16_t;
typedef short bf16x8 __attribute__((ext_vector_type(8)));
typedef float f32x4 __attribute__((ext_vector_type(4)));
typedef unsigned u32x4 __attribute__((ext_vector_type(4)));
constexpr int BM = 256, BK = 64, HALF = 128, HTB = HALF * BK * 2  , STAGE_BYTES = 8 * HTB, NXCD = 8, WGM = 8;

__host__ __device__ __forceinline__ int lds_byte(int r, int c) { const int st = (r >> 4) * 2 + (c >> 5), rr = r & 15, cc = c & 31, ob = rr * 64 + cc * 2; return st * 1024 + (ob ^ (((ob >> 9) & 1) << 5)); }
__host__ __device__ __forceinline__ void stage_rc(int b, int& R, int& C) { const int st = b / 1024, sb = b % 1024, swz = sb ^ (((sb >> 9) & 1) << 5); R = (st >> 1) * 16 + swz / 64; C = (st & 1) * 32 + (swz % 64) / 2; }
__host__ __device__ __forceinline__ int perm32(int rho) { const int n = rho >> 4, i = rho & 15; return 8 * (i >> 2) + 4 * n + (i & 3); }

struct Unit { int pm, pn; };
struct Gemm { const bf16_t* A; const bf16_t* Bt; int M, N, K; };

struct StaticOrder {
    int nM, nN, nwg, G, c;
    __host__ __device__ void init(int M, int N, int G_, int c_) { nM = M / BM; nN = N / BM; nwg = nM * nN; G = G_; c = c_; }
    __host__ __device__ bool next(int i, Unit& u) const {
        const long L = (long)i * G + c; if (L >= nwg) return false;
        int wgid = (int)L; { const int q = nwg / NXCD, r = nwg % NXCD, xcd = wgid % NXCD, off = wgid / NXCD; wgid = (xcd < r ? xcd * (q + 1) : r * (q + 1) + (xcd - r) * q) + off; }
        const int nig = WGM * nN, gid = wgid / nig, fm = gid * WGM, gsz = (nM - fm) < WGM ? (nM - fm) : WGM;
        u.pm = fm + ((wgid % nig) % gsz); u.pn = (wgid % nig) / gsz; return true;
    }
    __device__ __forceinline__ void a_ready(const Unit&) const {}
    __device__ __forceinline__ void done(const Unit&) const {}
};

__device__ __forceinline__ unsigned cvt_pk_bf16(float lo, float hi) { unsigned r; asm volatile("v_cvt_pk_bf16_f32 %0, %1, %2" : "=v"(r) : "v"(lo), "v"(hi)); return r; }
typedef float f32x2 __attribute__((ext_vector_type(2)));
typedef int i32x8 __attribute__((ext_vector_type(8)));
typedef int i32x4v __attribute__((ext_vector_type(4)));
__device__ __forceinline__ i32x8 cat8(bf16x8 lo, bf16x8 hi) { const i32x4v a = __builtin_bit_cast(i32x4v, lo), b = __builtin_bit_cast(i32x4v, hi); return __builtin_shufflevector(a, b, 0, 1, 2, 3, 4, 5, 6, 7); }
template <class Epi, class Sched, bool ALIGN_EPI = false, bool SP2 = false, bool FP8 = false>
__device__ __forceinline__ void gemm_phase(PG8_LAS unsigned char* lds, const Gemm g, const Sched& S, const Epi& E) {
    int tid_ = threadIdx.x; asm volatile("" : "+v"(tid_));
    const int tid = tid_, wid = __builtin_amdgcn_readfirstlane(tid >> 6), lane = tid & 63, wr = wid >> 2, wc = wid & 3, fr = lane & 15, fq = lane >> 4;
    const int K = g.K, nt = K / BK;
    unsigned voffA[2], voffB[2];
#pragma unroll
    for (int i = 0; i < 2; ++i) { int R, C; stage_rc(tid * 16 + i * 8192, R, C); const int Rb = Epi::PERM ? ((R & ~31) + perm32(R & 31)) : R;
        voffA[i] = (unsigned)(R * K + C) * 2u; voffB[i] = (unsigned)(Rb * K + C) * 2u; }
    const size_t kstep = (size_t)(BK * 2);
    const size_t hstep = (size_t)HALF * K * 2;
    const size_t tstep = 2 * hstep;
    const unsigned ldsw = (unsigned)wid * 1024u;
    const int aoff = lds_byte(wr * 64 + fr, fq * 8), boff = lds_byte(wc * 32 + fr, fq * 8);
#define PG8_SA(b, h) (((b) * 2 + (h)) * HTB)
#define PG8_SB(b, h) ((4 + (b) * 2 + (h)) * HTB)
#define PG8_STAGE(bufoff, gbase, voff) do { _Pragma("unroll") for (int _i = 0; _i < 2; ++_i) \
        __builtin_amdgcn_global_load_lds((const unsigned*)((const char*)(gbase) + (voff)[_i]), (PG8_LAS unsigned*)(lds + (bufoff) + ldsw + _i * 8192), 16, 0, 0); } while (0)
#define PG8_LDA(dst, b, h) do { if constexpr (FP8) { _Pragma("unroll") for (int m = 0; m < 4; ++m) dst##8[m] = cat8(*(const PG8_LAS bf16x8*)(lds + PG8_SA(b, h) + aoff + m * 2048), *(const PG8_LAS bf16x8*)(lds + PG8_SA(b, h) + aoff + m * 2048 + 1024)); } \
        else { _Pragma("unroll") for (int m = 0; m < 4; ++m) _Pragma("unroll") for (int k = 0; k < 2; ++k) dst[m][k] = *(const PG8_LAS bf16x8*)(lds + PG8_SA(b, h) + aoff + m * 2048 + k * 1024); } } while (0)
#define PG8_LDB(dst, b, h) do { if constexpr (FP8) { _Pragma("unroll") for (int n = 0; n < 2; ++n) dst##8[n] = cat8(*(const PG8_LAS bf16x8*)(lds + PG8_SB(b, h) + boff + n * 2048), *(const PG8_LAS bf16x8*)(lds + PG8_SB(b, h) + boff + n * 2048 + 1024)); } \
        else { _Pragma("unroll") for (int n = 0; n < 2; ++n) _Pragma("unroll") for (int k = 0; k < 2; ++k) dst[n][k] = *(const PG8_LAS bf16x8*)(lds + PG8_SB(b, h) + boff + n * 2048 + k * 1024); } } while (0)
#define PG8_MMA(ai, bj, At, Bt) do { __builtin_amdgcn_s_setprio(1); \
        if constexpr (FP8) { _Pragma("unroll") for (int m = 0; m < 4; ++m) _Pragma("unroll") for (int n = 0; n < 2; ++n) \
            asm volatile("v_mfma_f32_16x16x128_f8f6f4 %0, %1, %2, %0" : "+v"(acc[ai][bj][m][n]) : "v"(Bt##8[n]), "v"(At##8[m])); } \
        else { _Pragma("unroll") for (int m = 0; m < 4; ++m) _Pragma("unroll") for (int n = 0; n < 2; ++n) _Pragma("unroll") for (int k = 0; k < 2; ++k) \
            acc[ai][bj][m][n] = __builtin_amdgcn_mfma_f32_16x16x32_bf16(Bt[n][k], At[m][k], acc[ai][bj][m][n], 0, 0, 0); } \
        __builtin_amdgcn_s_setprio(0); } while (0)
#define PG8_WAIT_V(n) asm volatile("s_waitcnt vmcnt(" #n ")" ::: "memory")
#define PG8_WAIT_L(n) asm volatile("s_waitcnt lgkmcnt(" #n ")" ::: "memory")
#define PG8_BAR __builtin_amdgcn_s_barrier()
#define PG8_SCHED __builtin_amdgcn_sched_barrier(0)
    Unit cur, nxt; int ui = 0;
    if (!S.next(0, cur)) return;
    f32x4 acc[2][2][4][2];
#pragma unroll
    for (int a = 0; a < 2; ++a)
#pragma unroll
        for (int b = 0; b < 2; ++b)
#pragma unroll
            for (int m = 0; m < 4; ++m)
#pragma unroll
                for (int n = 0; n < 2; ++n) acc[a][b][m][n] = (f32x4){0.f, 0.f, 0.f, 0.f};
    bf16x8 At[4][2], B0[2][2], B1[2][2];
    i32x8 At8[4], B08[2], B18[2];
    const char* cA = (const char*)g.A + (size_t)cur.pm * tstep; const char* cB = (const char*)g.Bt + (size_t)cur.pn * tstep;
    S.a_ready(cur);
    if constexpr (SP2) {
        PG8_STAGE(PG8_SB(0, 0), cB, voffB); PG8_STAGE(PG8_SB(0, 1), cB + hstep, voffB); PG8_STAGE(PG8_SA(0, 0), cA, voffA); PG8_STAGE(PG8_SA(0, 1), cA + hstep, voffA);
        if (wr == 1) PG8_BAR;
        PG8_WAIT_V(2); PG8_BAR;
        PG8_STAGE(PG8_SB(1, 0), cB + kstep, voffB); PG8_STAGE(PG8_SA(1, 0), cA + kstep, voffA); PG8_STAGE(PG8_SB(1, 1), cB + hstep + kstep, voffB);
        PG8_WAIT_V(6); PG8_BAR;
    } else {
        PG8_STAGE(PG8_SB(0, 0), cB, voffB); PG8_STAGE(PG8_SA(0, 0), cA, voffA); PG8_STAGE(PG8_SB(0, 1), cB + hstep, voffB); PG8_STAGE(PG8_SA(0, 1), cA + hstep, voffA);
        if (wr == 1) PG8_BAR;
        PG8_WAIT_V(4); PG8_BAR;
        PG8_STAGE(PG8_SB(1, 0), cB + kstep, voffB); PG8_STAGE(PG8_SA(1, 0), cA + kstep, voffA); PG8_STAGE(PG8_SB(1, 1), cB + hstep + kstep, voffB);
        PG8_WAIT_V(6); PG8_BAR;
    }
    for (;;) {
        const bool has_next = S.next(ui + 1, nxt);
        const char* nA = has_next ? (const char*)g.A + (size_t)nxt.pm * tstep : cA; const char* nB = has_next ? (const char*)g.Bt + (size_t)nxt.pn * tstep : cB;
        for (int t = 0; t < nt; t += 2) {
            const bool last = (t == nt - 2);
            if constexpr (Epi::HAS_MID) { if (t == (nt >> 1)) { if constexpr (FP8) asm volatile("s_nop 7\n\ts_nop 7\n\ts_nop 7" ::: "memory"); E.mid(acc, cur, wr, wc, fr, fq); } }
            const char* a1 = cA + (size_t)(t + 1) * kstep;
            const char* a2 = last ? nA : cA + (size_t)(t + 2) * kstep; const char* b2 = last ? nB : cB + (size_t)(t + 2) * kstep;
            const char* a3 = a2 + kstep; const char* b3 = b2 + kstep;
            if (last && has_next) S.a_ready(nxt);
            if constexpr (SP2) {
            PG8_LDB(B0, 0, 0); PG8_LDB(B1, 0, 1); PG8_SCHED; PG8_LDA(At, 0, 0); PG8_STAGE(PG8_SA(1, 1), a1 + hstep, voffA);
            PG8_WAIT_V(8); PG8_WAIT_L(0); PG8_BAR; PG8_MMA(0, 0, At, B0); PG8_MMA(0, 1, At, B1); PG8_BAR; PG8_SCHED;
            PG8_LDA(At, 0, 1); PG8_STAGE(PG8_SB(0, 0), b2, voffB); PG8_STAGE(PG8_SB(0, 1), b2 + hstep, voffB); PG8_STAGE(PG8_SA(0, 0), a2, voffA);
            PG8_WAIT_V(8); PG8_WAIT_L(0); PG8_BAR; PG8_MMA(1, 0, At, B0); PG8_MMA(1, 1, At, B1); PG8_BAR; PG8_SCHED;
            PG8_LDB(B0, 1, 0); PG8_LDB(B1, 1, 1); PG8_SCHED; PG8_LDA(At, 1, 0); PG8_STAGE(PG8_SA(0, 1), a2 + hstep, voffA);
            PG8_WAIT_V(8); PG8_WAIT_L(0); PG8_BAR; PG8_MMA(0, 0, At, B0); PG8_MMA(0, 1, At, B1); PG8_BAR; PG8_SCHED;
            PG8_LDA(At, 1, 1); PG8_STAGE(PG8_SB(1, 0), b3, voffB); PG8_STAGE(PG8_SB(1, 1), b3 + hstep, voffB); PG8_STAGE(PG8_SA(1, 0), a3, voffA);
            PG8_WAIT_V(8); PG8_WAIT_L(0); PG8_BAR; PG8_MMA(1, 0, At, B0); PG8_MMA(1, 1, At, B1); PG8_BAR; PG8_SCHED;
            } else {
            PG8_LDB(B0, 0, 0); PG8_SCHED; PG8_LDA(At, 0, 0); PG8_STAGE(PG8_SA(1, 1), a1 + hstep, voffA);
            PG8_WAIT_L(8); PG8_BAR; PG8_WAIT_L(0); PG8_MMA(0, 0, At, B0); PG8_BAR; PG8_SCHED;
            PG8_LDB(B1, 0, 1); PG8_STAGE(PG8_SB(0, 0), b2, voffB);
            PG8_BAR; PG8_WAIT_L(0); PG8_MMA(0, 1, At, B1); PG8_BAR;
            PG8_LDA(At, 0, 1); PG8_STAGE(PG8_SA(0, 0), a2, voffA);
            PG8_BAR; PG8_WAIT_L(0); PG8_MMA(1, 0, At, B0); PG8_BAR; PG8_SCHED;
            PG8_STAGE(PG8_SB(0, 1), b2 + hstep, voffB);
            PG8_WAIT_V(6); PG8_BAR; PG8_MMA(1, 1, At, B1); PG8_BAR;
            PG8_LDB(B0, 1, 0); PG8_SCHED; PG8_LDA(At, 1, 0); PG8_STAGE(PG8_SA(0, 1), a2 + hstep, voffA);
            PG8_WAIT_L(8); PG8_BAR; PG8_WAIT_L(0); PG8_MMA(0, 0, At, B0); PG8_BAR; PG8_SCHED;
            PG8_LDB(B1, 1, 1); PG8_STAGE(PG8_SB(1, 0), b3, voffB);
            PG8_BAR; PG8_WAIT_L(0); PG8_MMA(0, 1, At, B1); PG8_BAR;
            PG8_LDA(At, 1, 1); PG8_STAGE(PG8_SA(1, 0), a3, voffA);
            PG8_BAR; PG8_WAIT_L(0); PG8_MMA(1, 0, At, B0); PG8_BAR; PG8_SCHED;
            PG8_STAGE(PG8_SB(1, 1), b3 + hstep, voffB);
            PG8_WAIT_V(6); PG8_BAR; PG8_MMA(1, 1, At, B1); PG8_BAR;
            }
        }
        if constexpr (ALIGN_EPI) { if (wr == 0) PG8_BAR; }
        if constexpr (FP8) asm volatile("s_nop 7\n\ts_nop 7\n\ts_nop 7" ::: "memory");
        if constexpr (!Epi::AFTER_DRAIN) { E(acc, cur, wr, wc, fr, fq); S.done(cur); }
        if (!has_next) break;
#pragma unroll
        for (int a = 0; a < 2; ++a)
#pragma unroll
            for (int b = 0; b < 2; ++b)
#pragma unroll
                for (int m = 0; m < 4; ++m)
#pragma unroll
                    for (int n = 0; n < 2; ++n) acc[a][b][m][n] = (f32x4){0.f, 0.f, 0.f, 0.f};
        cur = nxt; cA = nA; cB = nB; ++ui;
        if constexpr (ALIGN_EPI) { if (wr == 1) PG8_BAR; }
    }
    PG8_WAIT_V(0);
    if constexpr (!ALIGN_EPI) { if (wr == 0) PG8_BAR; }
    PG8_BAR;
    if constexpr (Epi::AFTER_DRAIN) { E.fused(acc, cur, wr, wc, fr, fq, lds, wid, lane); S.done(cur); }
#undef PG8_SA
#undef PG8_SB
#undef PG8_STAGE
#undef PG8_LDA
#undef PG8_LDB
#undef PG8_MMA
#undef PG8_WAIT_V
#undef PG8_WAIT_L
#undef PG8_BAR
#undef PG8_SCHED
}
}

#define LAS __attribute__((address_space(3)))
typedef unsigned short bf16;
typedef float f32x4 __attribute__((ext_vector_type(4)));
typedef unsigned u32x4 __attribute__((ext_vector_type(4)));
typedef unsigned u32x2 __attribute__((ext_vector_type(2)));
typedef short bf16x8 __attribute__((ext_vector_type(8)));
using pg8::cvt_pk_bf16;

constexpr int NWAVES = 8, NTHR = 512;
constexpr int DM = 4096, NP = 4096, NS = 2048, MT = 6144, NKV = 7168;
constexpr int QL = 1024, KVL = 512, RD = 64, MLAW = 2048, S5W = 2048;
constexpr int INC = 15936, INP = 16128;
constexpr float LN_EPS = 1e-6f;
constexpr float ALPHA = 1.189207115002721f;

constexpr size_t MiB = 1u << 20;
constexpr size_t WS_CTL = 0, CTL_ZERO_BYTES = 64 * 1024;
constexpr size_t WS_MODP = 1 * MiB;
constexpr size_t WS_MOD = WS_MODP + 768 * 1024;
constexpr size_t WS_WIN8 = 2 * MiB;
constexpr size_t WS_WINB = 66 * MiB;
constexpr size_t WS_WUQ8 = 88 * MiB;
constexpr size_t WS_WK8 = 91 * MiB;
constexpr size_t WS_WV8 = 92 * MiB;
constexpr size_t WS_WGLU8 = 93 * MiB;
constexpr size_t WS_WPAB8 = 97 * MiB;
constexpr size_t WS_WO8 = 113 * MiB;
constexpr size_t WS_H8 = 130 * MiB;
constexpr size_t WS_H = 154 * MiB;
constexpr size_t WS_CQ = 186 * MiB;
constexpr size_t WS_CKVR = 210 * MiB;
constexpr size_t WS_KPE = 222 * MiB;
constexpr size_t WS_UB = 224 * MiB;
constexpr size_t WS_SZA = 272 * MiB;
constexpr size_t WS_SZB = 296 * MiB;
constexpr size_t WS_SGA = 320 * MiB;
constexpr size_t WS_SGB = 368 * MiB;
constexpr size_t WS_CQN8 = 416 * MiB;
constexpr size_t WS_CKV8 = 422 * MiB;
constexpr size_t WS_KPEB = 426 * MiB;
constexpr size_t WS_Q = 428 * MiB;
constexpr size_t WS_KN = 464 * MiB;
constexpr size_t WS_VT = 492 * MiB;
constexpr size_t WS_YS5 = 520 * MiB;
constexpr size_t WS_Y5 = 616 * MiB;
constexpr size_t WS_Y58 = 640 * MiB;
constexpr size_t WS_AB8 = 652 * MiB;
constexpr size_t WS_MG8 = 676 * MiB;
constexpr size_t WS_END = 700 * MiB;
constexpr float S_WIN = 64.f, S_WUQ = 32.f, S_WKV = 16.f, S_WGLU = 32.f, S_WP = 64.f, S_WO = 64.f, S_Y5 = 4.f, S_AB = 4.f, S_MG = 16.f;

constexpr size_t O_Y = 0, O_CKV = (size_t)MT * DM, O_KPE = O_CKV + (size_t)NP * KVL, O_SRE = O_KPE + (size_t)NP * RD, O_SIM = O_SRE + 16 * 2 * 128 * 64;

constexpr int LDS_BYTES = 147456;
#ifndef REPEAT_MASK
#define REPEAT_MASK 0
#endif
#define NREP(k) (((REPEAT_MASK >> (k)) & 1) ? 2 : 1)
#ifndef PHASE_MASK
#define PHASE_MASK 0x1ff
#endif

#define LDS_WAIT() asm volatile("s_waitcnt lgkmcnt(0)" ::: "memory")
#define VM_WAIT() asm volatile("s_waitcnt vmcnt(0)" ::: "memory")

__device__ __forceinline__ unsigned f2bf(float f) { unsigned u = __builtin_bit_cast(unsigned, f); return (u + 0x7fffu + ((u >> 16) & 1u)) >> 16; }
__device__ __forceinline__ float bf2f(unsigned b) { return __builtin_bit_cast(float, b << 16); }
__device__ __forceinline__ float bflo(unsigned w) { return __builtin_bit_cast(float, w << 16); }
__device__ __forceinline__ float bfhi(unsigned w) { return __builtin_bit_cast(float, w & 0xffff0000u); }
__device__ __forceinline__ float clamp8(float x) { return __builtin_amdgcn_fmed3f(x, -448.0f, 448.0f); }
__device__ __forceinline__ unsigned pk_fp8x4(float a, float b, float c, float d) {
    int r = __builtin_amdgcn_cvt_pk_fp8_f32(clamp8(a), clamp8(b), 0, false); r = __builtin_amdgcn_cvt_pk_fp8_f32(clamp8(c), clamp8(d), r, true); return (unsigned)r; }
__device__ __forceinline__ float fast_rcp(float x) { return __builtin_amdgcn_rcpf(x); }
__device__ __forceinline__ float sigmoidf_(float x) { return fast_rcp(1.0f + __expf(-x)); }
__device__ __forceinline__ float siluf_(float x) { return x * sigmoidf_(x); }
__device__ __forceinline__ float gelu_tanh(float x) {
    const float z = 0.7978845608028654f * (x + 0.044715f * x * x * x);
    const float t = 1.0f - 2.0f * fast_rcp(__expf(2.0f * z) + 1.0f);
    return 0.5f * x * (1.0f + t);
}
__device__ __forceinline__ float wave_sum(float v) {
#pragma unroll
    for (int o = 1; o < 64; o <<= 1) v += __shfl_xor(v, o);
    return v;
}
__device__ __forceinline__ void sincos_acc(float x, float& s, float& c) {
    const float k = rintf(x * 0.15915494309189535f);
    float r = fmaf(-k, 6.2831854820251465f, x);
    r = fmaf(-k, -1.7484555e-7f, r);
    float sgn = 1.0f;
    if (r > 1.5707963267948966f) { r = 3.14159274101257324f - r; r += -8.742278e-8f; sgn = -1.0f; }
    else if (r < -1.5707963267948966f) { r = -3.14159274101257324f - r; r -= -8.742278e-8f; sgn = -1.0f; }
    const float r2 = r * r;
    float ps = 1.0f / 6227020800.0f;
    ps = fmaf(ps, r2, -1.0f / 39916800.0f); ps = fmaf(ps, r2, 1.0f / 362880.0f); ps = fmaf(ps, r2, -1.0f / 5040.0f);
    ps = fmaf(ps, r2, 1.0f / 120.0f); ps = fmaf(ps, r2, -1.0f / 6.0f);
    s = fmaf(ps * r2, r, r);
    float pc = -1.0f / 87178291200.0f;
    pc = fmaf(pc, r2, 1.0f / 479001600.0f); pc = fmaf(pc, r2, -1.0f / 3628800.0f); pc = fmaf(pc, r2, 1.0f / 40320.0f);
    pc = fmaf(pc, r2, -1.0f / 720.0f); pc = fmaf(pc, r2, 1.0f / 24.0f); pc = fmaf(pc, r2, -0.5f);
    c = sgn * fmaf(pc, r2, 1.0f);
}
__device__ __forceinline__ float rope_inv(int i) { return exp2f(-(float)i * (13.287712379549449f / 16.0f)); }

__device__ __forceinline__ void p0_tile(const float* __restrict__ W, int ldw, int k0, int n0, unsigned char* W8, bf16* WB, float sc, int ldk, int drow0, int koff, LAS float* scr, int lane) {
    const int n4 = lane & 15, kq = lane >> 4;
    f32x4 v[16];
#pragma unroll
    for (int i = 0; i < 16; ++i) v[i] = *(const f32x4*)(W + (size_t)(k0 + 4 * i + kq) * ldw + n0 + 4 * n4);
#pragma unroll
    for (int i = 0; i < 16; ++i) { const int kk = 4 * i + kq;
        scr[(4 * n4 + 0) * 65 + kk] = v[i].x; scr[(4 * n4 + 1) * 65 + kk] = v[i].y; scr[(4 * n4 + 2) * 65 + kk] = v[i].z; scr[(4 * n4 + 3) * 65 + kk] = v[i].w; }
    LDS_WAIT();
    const int c = lane & 7;
#pragma unroll
    for (int j = 0; j < 8; ++j) { const int n = (lane >> 3) + 8 * j; const LAS float* s = scr + n * 65 + 8 * c;
        const float a0 = s[0], a1 = s[1], a2 = s[2], a3 = s[3], a4 = s[4], a5 = s[5], a6 = s[6], a7 = s[7];
        u32x2 q; q.x = pk_fp8x4(a0 * sc, a1 * sc, a2 * sc, a3 * sc); q.y = pk_fp8x4(a4 * sc, a5 * sc, a6 * sc, a7 * sc);
        *(u32x2*)(W8 + (size_t)(drow0 + n) * ldk + koff + k0 + 8 * c) = q;
        if (WB) { u32x4 o; o.x = cvt_pk_bf16(a0, a1); o.y = cvt_pk_bf16(a2, a3); o.z = cvt_pk_bf16(a4, a5); o.w = cvt_pk_bf16(a6, a7);
            *(u32x4*)(WB + (size_t)(drow0 + n) * ldk + koff + k0 + 8 * c) = o; } }
    LDS_WAIT();
}

struct EpiIn {
    static constexpr bool PERM = true, AFTER_DRAIN = false, HAS_MID = false;
    float* cq; float* ckvr; float* kpe; float* ub; bf16* sza; bf16* szb; bf16* sga; bf16* sgb; int pm_off, pn_off; float sc;
    __device__ __forceinline__ void operator()(const f32x4 (&acc)[2][2][4][2], const pg8::Unit& u, int wr, int wc, int fr, int fq) const {
        const int pn = u.pn + pn_off;
        int mode, ld, cb, ncol = 256; float* fp = nullptr; bf16* bp = nullptr;
        if (pn < 2) { mode = 0; fp = ckvr; ld = KVL; cb = pn * 256; }
        else if (pn < 3) { mode = 0; fp = kpe; ld = RD; cb = 0; ncol = 64; }
        else if (pn < 11) { mode = 0; fp = ub; ld = S5W; cb = (pn - 3) * 256; }
        else if (pn < 15) { mode = 0; fp = cq; ld = QL; cb = (pn - 11) * 256; }
        else if (pn < 23) { mode = 1; bp = sza; ld = MLAW; cb = (pn - 15) * 256; }
        else if (pn < 31) { mode = 1; bp = szb; ld = S5W; cb = (pn - 23) * 256; }
        else if (pn < 47) { mode = 2; bp = sga; ld = DM; cb = (pn - 31) * 256; }
        else { mode = 2; bp = sgb; ld = DM; cb = (pn - 47) * 256; }
        int zero_; asm volatile("v_mov_b32 %0, 0" : "=v"(zero_));
        const int row0 = (u.pm + pm_off) * 256 + wr * 64 + fr + zero_, c0 = wc * 32 + 8 * fq;
#pragma unroll
        for (int ai = 0; ai < 2; ++ai)
#pragma unroll
            for (int m = 0; m < 4; ++m) { const size_t row = (size_t)(row0 + ai * 128 + m * 16);
#pragma unroll
                for (int bj = 0; bj < 2; ++bj) { const int c = bj * 128 + c0; const f32x4 v0 = acc[ai][bj][m][0] * sc, v1 = acc[ai][bj][m][1] * sc;
                    if (mode == 0) { if (c < ncol) { float* p = fp + row * ld + cb + c; *(f32x4*)p = v0; *(f32x4*)(p + 4) = v1; } }
                    else { float a[8] = {v0[0], v0[1], v0[2], v0[3], v1[0], v1[1], v1[2], v1[3]};
#pragma unroll
                        for (int e = 0; e < 8; ++e) { const float sg = sigmoidf_(a[e]); a[e] = (mode == 1) ? a[e] * sg : sg; }
                        u32x4 w; w.x = cvt_pk_bf16(a[0], a[1]); w.y = cvt_pk_bf16(a[2], a[3]); w.z = cvt_pk_bf16(a[4], a[5]); w.w = cvt_pk_bf16(a[6], a[7]);
                        *(u32x4*)(bp + row * ld + cb + c) = w; } } }
    }
};
struct EpiStore {
    static constexpr bool PERM = true, AFTER_DRAIN = false, HAS_MID = false;
    bf16* O; int ldc; float sc;
    __device__ __forceinline__ void operator()(const f32x4 (&acc)[2][2][4][2], const pg8::Unit& u, int wr, int wc, int fr, int fq) const {
        int zero_; asm volatile("v_mov_b32 %0, 0" : "=v"(zero_));
        const int row0 = u.pm * 256 + wr * 64 + fr + zero_, c0 = u.pn * 256 + wc * 32 + 8 * fq;
#pragma unroll
        for (int ai = 0; ai < 2; ++ai)
#pragma unroll
            for (int m = 0; m < 4; ++m) { bf16* rp = O + (size_t)(row0 + ai * 128 + m * 16) * ldc + c0;
#pragma unroll
                for (int bj = 0; bj < 2; ++bj) { const f32x4 v0 = acc[ai][bj][m][0] * sc, v1 = acc[ai][bj][m][1] * sc;
                    u32x4 w; w.x = cvt_pk_bf16(v0[0], v0[1]); w.y = cvt_pk_bf16(v0[2], v0[3]); w.z = cvt_pk_bf16(v1[0], v1[1]); w.w = cvt_pk_bf16(v1[2], v1[3]);
                    *(u32x4*)(rp + bj * 128) = w; } }
    }
};
struct EpiGlu {
    static constexpr bool PERM = true, AFTER_DRAIN = false, HAS_MID = false;
    const bf16* y5; const bf16* szb; const float* bglu; unsigned char* ab8; float sc;
    __device__ __forceinline__ void operator()(const f32x4 (&acc)[2][2][4][2], const pg8::Unit& u, int wr, int wc, int fr, int fq) const {
        int zero_; asm volatile("v_mov_b32 %0, 0" : "=v"(zero_));
        const int row0 = u.pm * 256 + wr * 64 + fr + zero_, c0 = u.pn * 256 + wc * 32 + 8 * fq;
#pragma unroll
        for (int bj = 0; bj < 2; ++bj) { const int c = c0 + bj * 128; const f32x4 b0 = *(const f32x4*)(bglu + c), b1 = *(const f32x4*)(bglu + c + 4);
#pragma unroll
            for (int ai = 0; ai < 2; ++ai)
#pragma unroll
                for (int m = 0; m < 4; ++m) { const size_t row = (size_t)(row0 + ai * 128 + m * 16);
                    const u32x4 yv = *(const u32x4*)(y5 + row * S5W + c), zv = *(const u32x4*)(szb + row * S5W + c);
                    const f32x4 v0 = acc[ai][bj][m][0] * sc + b0, v1 = acc[ai][bj][m][1] * sc + b1;
                    float r[8];
                    r[0] = bflo(yv.x) * sigmoidf_(v0[0]) * bflo(zv.x); r[1] = bfhi(yv.x) * sigmoidf_(v0[1]) * bfhi(zv.x);
                    r[2] = bflo(yv.y) * sigmoidf_(v0[2]) * bflo(zv.y); r[3] = bfhi(yv.y) * sigmoidf_(v0[3]) * bfhi(zv.y);
                    r[4] = bflo(yv.z) * sigmoidf_(v1[0]) * bflo(zv.z); r[5] = bfhi(yv.z) * sigmoidf_(v1[1]) * bfhi(zv.z);
                    r[6] = bflo(yv.w) * sigmoidf_(v1[2]) * bflo(zv.w); r[7] = bfhi(yv.w) * sigmoidf_(v1[3]) * bfhi(zv.w);
                    u32x2 w; w.x = pk_fp8x4(r[0] * S_AB, r[1] * S_AB, r[2] * S_AB, r[3] * S_AB); w.y = pk_fp8x4(r[4] * S_AB, r[5] * S_AB, r[6] * S_AB, r[7] * S_AB);
                    *(u32x2*)(ab8 + row * DM + MLAW + c) = w; } }
    }
};
struct EpiMerge {
    static constexpr bool PERM = true, AFTER_DRAIN = false, HAS_MID = true;
    const bf16* sga; const bf16* sgb; unsigned char* mg8; float sc;
    __device__ __forceinline__ void mid(f32x4 (&acc)[2][2][4][2], const pg8::Unit& u, int wr, int wc, int fr, int fq) const {
        int zero_; asm volatile("v_mov_b32 %0, 0" : "=v"(zero_));
        const int row0 = u.pm * 256 + wr * 64 + fr + zero_, c0 = u.pn * 256 + wc * 32 + 8 * fq;
#pragma unroll
        for (int ai = 0; ai < 2; ++ai)
#pragma unroll
            for (int m = 0; m < 4; ++m) { const size_t row = (size_t)(row0 + ai * 128 + m * 16);
#pragma unroll
                for (int bj = 0; bj < 2; ++bj) { const int c = c0 + bj * 128;
                    const u32x4 av = *(const u32x4*)(sga + row * DM + c), bv = *(const u32x4*)(sgb + row * DM + c);
                    f32x4 r0, r1;
                    r0[0] = bflo(av.x) * fast_rcp(bflo(bv.x)); r0[1] = bfhi(av.x) * fast_rcp(bfhi(bv.x)); r0[2] = bflo(av.y) * fast_rcp(bflo(bv.y)); r0[3] = bfhi(av.y) * fast_rcp(bfhi(bv.y));
                    r1[0] = bflo(av.z) * fast_rcp(bflo(bv.z)); r1[1] = bfhi(av.z) * fast_rcp(bfhi(bv.z)); r1[2] = bflo(av.w) * fast_rcp(bflo(bv.w)); r1[3] = bfhi(av.w) * fast_rcp(bfhi(bv.w));
                    acc[ai][bj][m][0] = acc[ai][bj][m][0] * r0; acc[ai][bj][m][1] = acc[ai][bj][m][1] * r1; }
                asm volatile("" ::: "memory"); }
    }
    __device__ __forceinline__ void operator()(const f32x4 (&acc)[2][2][4][2], const pg8::Unit& u, int wr, int wc, int fr, int fq) const {
        int zero_; asm volatile("v_mov_b32 %0, 0" : "=v"(zero_));
        const int row0 = u.pm * 256 + wr * 64 + fr + zero_, c0 = u.pn * 256 + wc * 32 + 8 * fq;
#pragma unroll
        for (int ai = 0; ai < 2; ++ai)
#pragma unroll
            for (int m = 0; m < 4; ++m) { const size_t row = (size_t)(row0 + ai * 128 + m * 16);
#pragma unroll
                for (int bj = 0; bj < 2; ++bj) { const int c = c0 + bj * 128; const f32x4 v0 = acc[ai][bj][m][0] * sc, v1 = acc[ai][bj][m][1] * sc;
                    const u32x4 bv = *(const u32x4*)(sgb + row * DM + c);
                    u32x2 w; w.x = pk_fp8x4(v0[0] * bflo(bv.x), v0[1] * bfhi(bv.x), v0[2] * bflo(bv.y), v0[3] * bfhi(bv.y));
                    w.y = pk_fp8x4(v1[0] * bflo(bv.z), v1[1] * bfhi(bv.z), v1[2] * bflo(bv.w), v1[3] * bfhi(bv.w));
                    *(u32x2*)(mg8 + row * DM + c) = w; } }
    }
};
struct EpiOut {
    static constexpr bool PERM = true, AFTER_DRAIN = false, HAS_MID = false;
    const float* xp; const float* xs; const float* gate; float* out; float sc;
    __device__ __forceinline__ void operator()(const f32x4 (&acc)[2][2][4][2], const pg8::Unit& u, int wr, int wc, int fr, int fq) const {
        const int rt = u.pm * 256; const int cond = rt < NP ? 0 : (rt < NP + 1024 ? 1 : 2);
        const float* xb = rt < NP ? xp : xs - (size_t)NP * DM;
        int zero_; asm volatile("v_mov_b32 %0, 0" : "=v"(zero_));
        const int row0 = rt + wr * 64 + fr + zero_, c0 = u.pn * 256 + wc * 32 + 8 * fq;
#pragma unroll
        for (int bj = 0; bj < 2; ++bj) { const int c = c0 + bj * 128; const f32x4 g0 = *(const f32x4*)(gate + cond * DM + c) * sc, g1 = *(const f32x4*)(gate + cond * DM + c + 4) * sc;
#pragma unroll
            for (int ai = 0; ai < 2; ++ai)
#pragma unroll
                for (int m = 0; m < 4; ++m) { const size_t off = (size_t)(row0 + ai * 128 + m * 16) * DM + c;
                    const f32x4 x0 = *(const f32x4*)(xb + off), x1 = *(const f32x4*)(xb + off + 4);
                    *(f32x4*)(out + off) = x0 * ALPHA + g0 * acc[ai][bj][m][0]; *(f32x4*)(out + off + 4) = x1 * ALPHA + g1 * acc[ai][bj][m][1]; } }
    }
};

constexpr int S5_WLDS = 10240 + 4352 + 1024;
__device__ __forceinline__ void s5_task(const float* ub, float* ys, int row0, int L, int g, int d,
                                        const float* __restrict__ a_re, const float* __restrict__ a_im, const float* __restrict__ log_dt,
                                        const float* __restrict__ b_re, const float* __restrict__ b_im, const float* __restrict__ c_re, const float* __restrict__ c_im,
                                        const float* h0re, const float* h0im, float* fre, float* fim, LAS unsigned char* wl, int lane) {
    LAS float* BuS = (LAS float*)wl; LAS unsigned char* Xs = wl + 10240; LAS float* par = (LAS float*)(wl + 10240 + 4352);
    const int fr = lane & 15, fq = lane >> 4;
    const int pg = d * 128 + g;
    float abr, abi;
    {
        const float ar = a_re[pg * 64 + lane], ai = a_im[pg * 64 + lane], dt = __expf(log_dt[pg]);
        const float mag = __expf(dt * ar); float sn, cs; sincos_acc(dt * ai, sn, cs);
        abr = mag * cs; abi = mag * sn;
        const float den = ar * ar + ai * ai, pr = abr - 1.0f;
        const float qr = (pr * ar + abi * ai) / den, qi = (abi * ar - pr * ai) / den;
        par[lane] = qr; par[64 + lane] = qi;
    }
    LDS_WAIT();
    bf16x8 Bre[4], Bim[4];
#pragma unroll
    for (int nb = 0; nb < 4; ++nb) { const int n = 16 * nb + fr; const float qr = par[n], qi = par[64 + n];
        const float* br = b_re + ((size_t)pg * 64 + n) * 16 + 8 * (fq & 1); const float* bi = b_im + ((size_t)pg * 64 + n) * 16 + 8 * (fq & 1);
        const f32x4 r0 = *(const f32x4*)br, r1 = *(const f32x4*)(br + 4), i0 = *(const f32x4*)bi, i1 = *(const f32x4*)(bi + 4);
        const f32x4 e0 = r0 * qr - i0 * qi, e1 = r1 * qr - i1 * qi, f0 = i0 * qr + r0 * qi, f1 = i1 * qr + r1 * qi;
        u32x4 wr_, wi_; wr_.x = cvt_pk_bf16(e0[0], e0[1]); wr_.y = cvt_pk_bf16(e0[2], e0[3]); wr_.z = cvt_pk_bf16(e1[0], e1[1]); wr_.w = cvt_pk_bf16(e1[2], e1[3]);
        wi_.x = cvt_pk_bf16(f0[0], f0[1]); wi_.y = cvt_pk_bf16(f0[2], f0[3]); wi_.z = cvt_pk_bf16(f1[0], f1[1]); wi_.w = cvt_pk_bf16(f1[2], f1[3]);
        Bre[nb] = __builtin_bit_cast(bf16x8, wr_); Bim[nb] = __builtin_bit_cast(bf16x8, wi_); }
    bf16x8 Cf[4];
#pragma unroll
    for (int ks = 0; ks < 4; ++ks) { const float* cp = ((ks < 2) ? c_re : c_im) + ((size_t)pg * 16 + fr) * 64 + 32 * (ks & 1) + 8 * fq; const float sg = (ks < 2) ? 1.0f : -1.0f;
        const f32x4 v0 = *(const f32x4*)cp * sg, v1 = *(const f32x4*)(cp + 4) * sg;
        u32x4 w; w.x = cvt_pk_bf16(v0[0], v0[1]); w.y = cvt_pk_bf16(v0[2], v0[3]); w.z = cvt_pk_bf16(v1[0], v1[1]); w.w = cvt_pk_bf16(v1[2], v1[3]);
        Cf[ks] = __builtin_bit_cast(bf16x8, w); }
    float xr = 0.f, xi = 0.f;
    if (h0re) { xr = h0re[lane]; xi = h0im[lane]; }
    const int nch = L >> 4;
    const int tl = d ? (15 - fr) : fr;
    const float* ucol = ub + (size_t)g * 16 + 8 * (fq & 1) + (size_t)(row0 + tl) * S5W;
    const int ystep = d ? -S5W : S5W;
    float* ycol = ys + (size_t)(row0 + (d ? 15 - 4 * fq : 4 * fq)) * S5W + g * 16 + fr;
    f32x4 un0, un1;
    { const int t0 = d ? (L - 16) : 0; const float* up = ucol + (size_t)t0 * S5W; un0 = *(const f32x4*)up; un1 = *(const f32x4*)(up + 4); }
    for (int ch = 0; ch < nch; ++ch) {
        const int t0 = d ? (L - 16 - 16 * ch) : 16 * ch;
        const f32x4 u0 = un0, u1 = un1;
        if (ch + 1 < nch) { const int t1 = d ? (t0 - 16) : (t0 + 16); const float* up = ucol + (size_t)t1 * S5W; un0 = *(const f32x4*)up; un1 = *(const f32x4*)(up + 4); }
        float uu[8] = {u0[0], u0[1], u0[2], u0[3], u1[0], u1[1], u1[2], u1[3]};
        if (fq >= 2) {
#pragma unroll
            for (int e = 0; e < 8; ++e) uu[e] = uu[e] - bf2f(f2bf(uu[e]));
        }
        u32x4 aw; aw.x = cvt_pk_bf16(uu[0], uu[1]); aw.y = cvt_pk_bf16(uu[2], uu[3]); aw.z = cvt_pk_bf16(uu[4], uu[5]); aw.w = cvt_pk_bf16(uu[6], uu[7]);
        const bf16x8 Af = __builtin_bit_cast(bf16x8, aw);
#pragma unroll
        for (int nb = 0; nb < 4; ++nb) {
            const f32x4 z = {0.f, 0.f, 0.f, 0.f};
            const f32x4 br = __builtin_amdgcn_mfma_f32_16x16x32_bf16(Af, Bre[nb], z, 0, 0, 0);
            const f32x4 bi = __builtin_amdgcn_mfma_f32_16x16x32_bf16(Af, Bim[nb], z, 0, 0, 0);
            *(LAS f32x4*)(BuS + (16 * nb + fr) * 20 + 4 * fq) = br;
            *(LAS f32x4*)(BuS + 1280 + (16 * nb + fr) * 20 + 4 * fq) = bi;
        }
        LDS_WAIT();
#pragma unroll
        for (int j = 0; j < 4; ++j) {
            const f32x4 vr = *(const LAS f32x4*)(BuS + lane * 20 + 4 * j), vi = *(const LAS f32x4*)(BuS + 1280 + lane * 20 + 4 * j);
#pragma unroll
            for (int i = 0; i < 4; ++i) {
                const float nr = fmaf(abr, xr, fmaf(-abi, xi, vr[i])), ni = fmaf(abr, xi, fmaf(abi, xr, vi[i]));
                xr = nr; xi = ni;
                *(LAS unsigned short*)(Xs + (4 * j + i) * 272 + lane * 2) = (unsigned short)f2bf(xr);
                *(LAS unsigned short*)(Xs + (4 * j + i) * 272 + 128 + lane * 2) = (unsigned short)f2bf(xi); } }
        LDS_WAIT();
        f32x4 y = {0.f, 0.f, 0.f, 0.f};
#pragma unroll
        for (int ks = 0; ks < 4; ++ks) { const bf16x8 xa = *(const LAS bf16x8*)(Xs + fr * 272 + (32 * ks + 8 * fq) * 2);
            y = __builtin_amdgcn_mfma_f32_16x16x32_bf16(xa, Cf[ks], y, 0, 0, 0); }
        float* yp = ycol + (size_t)t0 * S5W;
        yp[0] = y[0]; yp[ystep] = y[1]; yp[2 * ystep] = y[2]; yp[3 * ystep] = y[3];
        LDS_WAIT();
    }
    if (fre) { fre[lane] = xr; fim[lane] = xi; }
}

constexpr int ATT_KB = 64 * 400, ATT_VB = 128 * 144, ATT_BUF = ATT_KB + ATT_VB;
__device__ __forceinline__ void attn_unit(const bf16* Q, const bf16* KN, const bf16* KPEB, const bf16* VT, const bf16* sza, unsigned char* ab8,
                                          int qrow0, int h, int nt, int nt1, int key1, int key2, int rope_t0  ,
                                          LAS unsigned char* lds, int tid, int wave, int lane) {
    const int fr = lane & 15, fq = lane >> 4;
    bf16x8 qf[2][6];
#pragma unroll
    for (int qb = 0; qb < 2; ++qb) { const bf16* qp = Q + (size_t)(qrow0 + 32 * wave + 16 * qb + fr) * 3072 + h * 192 + 8 * fq;
#pragma unroll
        for (int ks = 0; ks < 6; ++ks) qf[qb][ks] = __builtin_bit_cast(bf16x8, *(const u32x4*)(qp + 32 * ks)); }
    if (rope_t0 >= 0) {
#pragma unroll
        for (int qb = 0; qb < 2; ++qb) { const int tq = rope_t0 + 32 * wave + 16 * qb + fr;
#pragma unroll
            for (int half = 0; half < 2; ++half) { const float pos = (float)(half == 0 ? (tq >> 6) : (tq & 63));
                u32x4 w = __builtin_bit_cast(u32x4, qf[qb][4 + half]);
                float v[8] = {bflo(w.x), bfhi(w.x), bflo(w.y), bfhi(w.y), bflo(w.z), bfhi(w.z), bflo(w.w), bfhi(w.w)};
                float o[8];
#pragma unroll
                for (int j = 0; j < 8; ++j) { const float pv = __shfl_xor(v[j], 32);
                    float sn, cs; sincos_acc(pos * rope_inv(8 * (fq & 1) + j), sn, cs);
                    o[j] = (fq < 2) ? (v[j] * cs - pv * sn) : (v[j] * cs + pv * sn); }
                w.x = cvt_pk_bf16(o[0], o[1]); w.y = cvt_pk_bf16(o[2], o[3]); w.z = cvt_pk_bf16(o[4], o[5]); w.w = cvt_pk_bf16(o[6], o[7]);
                qf[qb][4 + half] = __builtin_bit_cast(bf16x8, w); } }
    }
    f32x4 oacc[2][8];
#pragma unroll
    for (int qb = 0; qb < 2; ++qb)
#pragma unroll
        for (int db = 0; db < 8; ++db) oacc[qb][db] = (f32x4){0.f, 0.f, 0.f, 0.f};
    float mrun[2] = {-1e30f, -1e30f}, lrun[2] = {0.f, 0.f};
    const float SC = 0.07216878364870322f * 1.4426950408889634f;
    u32x4 sk0, sk1, sp, sv0, sv1;
    const int kr = tid >> 4, kc = tid & 15;
    const int pr = tid >> 3, pc = tid & 7;
    const int vr = tid >> 3, vc = tid & 7;
#define ATT_LOAD(t) do { const int key0_ = ((t) < nt1) ? key1 + 64 * (t) : key2 + 64 * ((t) - nt1); \
        sk0 = *(const u32x4*)(KN + (size_t)(key0_ + kr) * 2048 + h * 128 + 8 * kc); sk1 = *(const u32x4*)(KN + (size_t)(key0_ + kr + 32) * 2048 + h * 128 + 8 * kc); \
        sp = *(const u32x4*)(KPEB + (size_t)(key0_ + pr) * 64 + 8 * pc); \
        sv0 = *(const u32x4*)(VT + (size_t)(h * 128 + vr) * NKV + key0_ + 8 * vc); sv1 = *(const u32x4*)(VT + (size_t)(h * 128 + vr + 64) * NKV + key0_ + 8 * vc); } while (0)
#define ATT_STORE(b) do { LAS unsigned char* kb_ = lds + (b) * ATT_BUF; LAS unsigned char* vb_ = kb_ + ATT_KB; \
        *(LAS u32x4*)(kb_ + kr * 400 + kc * 16) = sk0; *(LAS u32x4*)(kb_ + (kr + 32) * 400 + kc * 16) = sk1; *(LAS u32x4*)(kb_ + pr * 400 + 256 + pc * 16) = sp; \
        *(LAS u32x4*)(vb_ + vr * 144 + vc * 16) = sv0; *(LAS u32x4*)(vb_ + (vr + 64) * 144 + vc * 16) = sv1; } while (0)
    ATT_LOAD(0); ATT_STORE(0);
    __syncthreads();
    for (int t = 0; t < nt; ++t) {
        if (t + 1 < nt) ATT_LOAD(t + 1);
        const LAS unsigned char* kb = lds + (t & 1) * ATT_BUF; const LAS unsigned char* vb = kb + ATT_KB;
        f32x4 s[2][4];
#pragma unroll
        for (int qb = 0; qb < 2; ++qb)
#pragma unroll
            for (int kb4 = 0; kb4 < 4; ++kb4) s[qb][kb4] = (f32x4){0.f, 0.f, 0.f, 0.f};
#pragma unroll
        for (int ks = 0; ks < 6; ++ks)
#pragma unroll
            for (int kb4 = 0; kb4 < 4; ++kb4) { const bf16x8 kf = *(const LAS bf16x8*)(kb + (16 * kb4 + fr) * 400 + (32 * ks + 8 * fq) * 2);
                s[0][kb4] = __builtin_amdgcn_mfma_f32_16x16x32_bf16(kf, qf[0][ks], s[0][kb4], 0, 0, 0);
                s[1][kb4] = __builtin_amdgcn_mfma_f32_16x16x32_bf16(kf, qf[1][ks], s[1][kb4], 0, 0, 0); }
        bf16x8 pf[2][2];
#pragma unroll
        for (int qb = 0; qb < 2; ++qb) {
            float mx = -1e30f;
#pragma unroll
            for (int kb4 = 0; kb4 < 4; ++kb4) mx = fmaxf(mx, fmaxf(fmaxf(s[qb][kb4][0], s[qb][kb4][1]), fmaxf(s[qb][kb4][2], s[qb][kb4][3])));
            mx = fmaxf(mx, __shfl_xor(mx, 16)); mx = fmaxf(mx, __shfl_xor(mx, 32));
            const float mnew = fmaxf(mrun[qb], mx * SC);
            if (__builtin_amdgcn_ballot_w64(mnew > mrun[qb]) != 0ull) {
                const float alpha = __builtin_amdgcn_exp2f(mrun[qb] - mnew); mrun[qb] = mnew; lrun[qb] *= alpha;
#pragma unroll
                for (int db = 0; db < 8; ++db) oacc[qb][db] = oacc[qb][db] * alpha;
            }
            float ps = 0.f;
#pragma unroll
            for (int kb4 = 0; kb4 < 4; ++kb4) {
#pragma unroll
                for (int i = 0; i < 4; ++i) { const float p = __builtin_amdgcn_exp2f(fmaf(s[qb][kb4][i], SC, -mnew)); s[qb][kb4][i] = p; ps += p; } }
            lrun[qb] += ps;
#pragma unroll
            for (int kk = 0; kk < 2; ++kk) { u32x4 w; w.x = cvt_pk_bf16(s[qb][2 * kk][0], s[qb][2 * kk][1]); w.y = cvt_pk_bf16(s[qb][2 * kk][2], s[qb][2 * kk][3]);
                w.z = cvt_pk_bf16(s[qb][2 * kk + 1][0], s[qb][2 * kk + 1][1]); w.w = cvt_pk_bf16(s[qb][2 * kk + 1][2], s[qb][2 * kk + 1][3]);
                pf[qb][kk] = __builtin_bit_cast(bf16x8, w); }
        }
#pragma unroll
        for (int db = 0; db < 8; ++db)
#pragma unroll
            for (int kk = 0; kk < 2; ++kk) { const LAS unsigned char* vp = vb + (16 * db + fr) * 144 + (32 * kk + 4 * fq) * 2;
                const u32x2 lo = *(const LAS u32x2*)vp, hi = *(const LAS u32x2*)(vp + 32);
                u32x4 w; w.x = lo.x; w.y = lo.y; w.z = hi.x; w.w = hi.y; const bf16x8 vf = __builtin_bit_cast(bf16x8, w);
                oacc[0][db] = __builtin_amdgcn_mfma_f32_16x16x32_bf16(vf, pf[0][kk], oacc[0][db], 0, 0, 0);
                oacc[1][db] = __builtin_amdgcn_mfma_f32_16x16x32_bf16(vf, pf[1][kk], oacc[1][db], 0, 0, 0); }
        if (t + 1 < nt) ATT_STORE((t + 1) & 1);
        __syncthreads();
    }
#undef ATT_LOAD
#undef ATT_STORE
#pragma unroll
    for (int qb = 0; qb < 2; ++qb) { float l = lrun[qb]; l += __shfl_xor(l, 16); l += __shfl_xor(l, 32); const float inv = 1.0f / l;
        const size_t row = (size_t)(qrow0 + 32 * wave + 16 * qb + fr);
#pragma unroll
        for (int db = 0; db < 8; ++db) { const int dcol = h * 128 + 16 * db + 4 * fq; const u32x2 zv = *(const u32x2*)(sza + row * MLAW + dcol); const f32x4 o = oacc[qb][db] * inv;
            *(unsigned*)(ab8 + row * DM + dcol) = pk_fp8x4(o[0] * bflo(zv.x) * S_AB, o[1] * bfhi(zv.x) * S_AB, o[2] * bflo(zv.y) * S_AB, o[3] * bfhi(zv.y) * S_AB); } }
}

#define XB_TMO      128
#define XB_XCNT(j)  (256  + 64 * (j))
#define XB_XSUB(j)  (1280 + 64 * (j))
#define XB_XGEN(j)  (2304 + 64 * (j))
#define XB_TOP      3328
#define XB_TOPGEN   3392
#define XCD_BAR_WORDS 3456
#define XB_SPIN_CAP (1u << 18)

__device__ __forceinline__ unsigned xb_ld(unsigned* p)              { return __hip_atomic_load(p, __ATOMIC_RELAXED, __HIP_MEMORY_SCOPE_AGENT); }
__device__ __forceinline__ unsigned xb_add(unsigned* p, unsigned v) { return __hip_atomic_fetch_add(p, v, __ATOMIC_RELAXED, __HIP_MEMORY_SCOPE_AGENT); }
__device__ __forceinline__ unsigned xb_xcc_id() { return (unsigned)__builtin_amdgcn_s_getreg((3 << 11) | 20) & 0xFu; }
#define XB_SPIN(cond, bar) do { unsigned _sp = 0; while (cond) { __builtin_amdgcn_s_sleep(1); \
    if ((++_sp & 255u) == 0u) { if (xb_ld(&(bar)[XB_TMO])) break; if (_sp > XB_SPIN_CAP) { atomicAdd(&(bar)[XB_TMO], 1u); break; } } } } while (0)

struct XcdBarrier {
    unsigned* bar; unsigned x;
    volatile LAS unsigned* st;
};

__device__ __forceinline__ XcdBarrier xcd_barrier_post(unsigned* bar, volatile LAS unsigned* st) {
    XcdBarrier b; b.bar = bar; b.x = xb_xcc_id(); b.st = st;
    if (threadIdx.x == 0) (void)xb_add(&bar[XB_XCNT(b.x)], 1u);
    return b;
}
__device__ __forceinline__ void xcd_barrier_complete(unsigned* bar, unsigned x, unsigned& nloc, unsigned& nx) {
    const unsigned G = gridDim.x * gridDim.y * gridDim.z;
    unsigned sum, cnt, mine, sp = 0u;
    for (;;) {
        sum = 0u; cnt = 0u; mine = 0u;
#pragma unroll
        for (unsigned j = 0; j < 16; ++j) { const unsigned c = xb_ld(&bar[XB_XCNT(j)]); sum += c; cnt += (c > 0u) ? 1u : 0u; mine = (j == x) ? c : mine; }
        if (sum == G) break;
        __builtin_amdgcn_s_sleep(1);
        if ((++sp & 255u) == 0u) { if (xb_ld(&bar[XB_TMO])) break; if (sp > XB_SPIN_CAP) { atomicAdd(&bar[XB_TMO], 1u); break; } }
    }
    nloc = mine > 0u ? mine : 1u; nx = cnt > 0u ? cnt : 1u;
}

__device__ __forceinline__ void xcd_barrier(const XcdBarrier& b) {
    asm volatile("s_waitcnt vmcnt(0)" ::: "memory");
    __syncthreads();
    if (threadIdx.x == 0) {
        unsigned* bar = b.bar;
        __builtin_amdgcn_s_waitcnt(0);
        unsigned nloc = b.st[0], nx = b.st[1];
        if (nloc == 0u) { xcd_barrier_complete(bar, b.x, nloc, nx); b.st[0] = nloc; b.st[1] = nx; }
        const unsigned old = xb_add(&bar[XB_XSUB(b.x)], 1u);
        const unsigned gen = old / nloc;
        if (old + 1u == (gen + 1u) * nloc) {
            __builtin_amdgcn_fence(__ATOMIC_RELEASE, "agent");
            asm volatile("s_waitcnt vmcnt(0)" ::: "memory");
            const unsigned og = xb_add(&bar[XB_TOP], 1u);
            const unsigned tg = og / nx;
            if (og + 1u == (tg + 1u) * nx) xb_add(&bar[XB_TOPGEN], 1u);
            else XB_SPIN(xb_ld(&bar[XB_TOPGEN]) == tg, bar);
            __builtin_amdgcn_fence(__ATOMIC_ACQUIRE, "agent");
            xb_add(&bar[XB_XGEN(b.x)], 1u);
            asm volatile("s_waitcnt vmcnt(0)" ::: "memory");
        } else {
            XB_SPIN(xb_ld(&bar[XB_XGEN(b.x)]) == gen, bar);
            __builtin_amdgcn_fence(__ATOMIC_ACQUIRE, "agent");
            asm volatile("s_waitcnt vmcnt(0)" ::: "memory");
        }
    }
    __syncthreads();
}

struct ListOrder {
    int n, pm0, pn0, pm1, pn1, pm2, pn2;
    __device__ __forceinline__ bool next(int i, pg8::Unit& u) const { if (i >= n) return false; u.pm = (i == 0) ? pm0 : ((i == 1) ? pm1 : pm2); u.pn = (i == 0) ? pn0 : ((i == 1) ? pn1 : pn2); return true; }
    __device__ __forceinline__ void a_ready(const pg8::Unit&) const {}
    __device__ __forceinline__ void done(const pg8::Unit&) const {}
};
struct Params { const float* in[30]; float* out; unsigned char* ws; };

#define out (P.out)
#define modp ((float*)(P.ws + WS_MODP))
#define gatev ((float*)(P.ws + WS_MOD))
#define WIN8 ((unsigned char*)(P.ws + WS_WIN8))
#define WINB ((bf16*)(P.ws + WS_WINB))
#define WUQ8 ((unsigned char*)(P.ws + WS_WUQ8))
#define WK8 ((unsigned char*)(P.ws + WS_WK8))
#define WV8 ((unsigned char*)(P.ws + WS_WV8))
#define WGLU8 ((unsigned char*)(P.ws + WS_WGLU8))
#define WPAB8 ((unsigned char*)(P.ws + WS_WPAB8))
#define WO8 ((unsigned char*)(P.ws + WS_WO8))
#define H8 ((unsigned char*)(P.ws + WS_H8))
#define H ((bf16*)(P.ws + WS_H))
#define CQ ((float*)(P.ws + WS_CQ))
#define CKVR ((float*)(P.ws + WS_CKVR))
#define KPE ((float*)(P.ws + WS_KPE))
#define UB ((float*)(P.ws + WS_UB))
#define SZA ((bf16*)(P.ws + WS_SZA))
#define SZB ((bf16*)(P.ws + WS_SZB))
#define SGA ((bf16*)(P.ws + WS_SGA))
#define SGB ((bf16*)(P.ws + WS_SGB))
#define CQN8 ((unsigned char*)(P.ws + WS_CQN8))
#define CKV8 ((unsigned char*)(P.ws + WS_CKV8))
#define KPEB ((bf16*)(P.ws + WS_KPEB))
#define Q ((bf16*)(P.ws + WS_Q))
#define KN ((bf16*)(P.ws + WS_KN))
#define VT ((bf16*)(P.ws + WS_VT))
#define YS5 ((float*)(P.ws + WS_YS5))
#define Y5 ((bf16*)(P.ws + WS_Y5))
#define Y58 ((unsigned char*)(P.ws + WS_Y58))
#define AB8 ((unsigned char*)(P.ws + WS_AB8))
#define MG8 ((unsigned char*)(P.ws + WS_MG8))
__device__ __forceinline__ const float* kin(int i) { unsigned off = 8u * (unsigned)i; asm volatile("" : "+s"(off)); return *(const float* const __attribute__((address_space(4)))*)((const char __attribute__((address_space(4)))*)__builtin_amdgcn_kernarg_segment_ptr() + off); }
__global__ void __launch_bounds__(NTHR, 2) hybrid_fwd(Params P) {
    extern __shared__ __attribute__((aligned(16))) unsigned char lds_raw[];
    LAS unsigned char* lds = (LAS unsigned char*)lds_raw;
    cg::grid_group grid = cg::this_grid();
    const int tid = threadIdx.x, lane = tid & 63, wave = __builtin_amdgcn_readfirstlane(tid >> 6);
    const int wg = blockIdx.x, G = gridDim.x;
    const int gw = wg * NWAVES + wave, NGW = G * NWAVES;
    volatile LAS unsigned* bst = (volatile LAS unsigned*)(lds + LDS_BYTES - 64);
    if (tid < 16) bst[tid] = 0u;
    __syncthreads();
    const XcdBarrier xbar = xcd_barrier_post((unsigned*)(P.ws + WS_CTL) + 1024, bst);
#define GRID_BAR() xcd_barrier(xbar)

    for (int rep_ = 0; rep_ < NREP(0); ++rep_) {
    if constexpr ((PHASE_MASK >> 0) & 1)
    {
        const float* const cache_ckv = kin(2);
        const float* const cache_kpe = kin(3);
        const float* const c_in = kin(6);
        const float* const c_ctx = kin(7);
        const float* const w_ada = kin(8);
        const float* const w_in = kin(10);
        LAS float* scr = (LAS float*)(lds + wave * 16640);
        constexpr int I_IN = 64 * 249;
        for (int it = gw; it < I_IN; it += NGW) {
            const int kb = it / 249, nb = it % 249, n0 = 64 * nb;
            int dr;
            if (n0 < 1024) dr = 2816 + n0; else if (n0 < 1536) dr = n0 - 1024; else if (n0 < 1600) dr = 512 + (n0 - 1536); else if (n0 < 3648) dr = 3840 + (n0 - 1600);
            else if (n0 < 5696) dr = 768 + (n0 - 3648); else if (n0 < 7744) dr = 5888 + (n0 - 5696); else if (n0 < 11840) dr = 7936 + (n0 - 7744); else dr = 12032 + (n0 - 11840);
            p0_tile(w_in, INC, 64 * kb, n0, WIN8, (dr < 2816) ? WINB : nullptr, S_WIN, DM, dr, 0, scr, lane);
        }
        for (int i = wg * NTHR + tid; i < (1024 * KVL) / 4; i += G * NTHR) { const f32x4 v = *(const f32x4*)(cache_ckv + 4 * (size_t)i);
            *(unsigned*)(CKV8 + (size_t)MT * KVL + 4 * (size_t)i) = pk_fp8x4(v[0], v[1], v[2], v[3]); }
        for (int i = wg * NTHR + tid; i < (1024 * RD) / 4; i += G * NTHR) { const f32x4 v = *(const f32x4*)(cache_kpe + 4 * (size_t)i);
            u32x2 w; w.x = cvt_pk_bf16(v[0], v[1]); w.y = cvt_pk_bf16(v[2], v[3]); *(u32x2*)(KPEB + (size_t)MT * RD + 4 * (size_t)i) = w; }
        __syncthreads();
        if (wg < 240) {
            const int slab = wg % 48, kc = wg / 48, k0 = (kc * 4096) / 5, k1 = ((kc + 1) * 4096) / 5;
            f32x4 a0 = {0.f, 0.f, 0.f, 0.f}, a1 = a0, a2 = a0;
            const float* wp = w_ada + slab * 256 + 4 * lane;
#pragma unroll 4
            for (int k = k0 + wave; k < k1; k += NWAVES) {
                const f32x4 w = *(const f32x4*)(wp + (size_t)k * 12288);
                const float s0 = siluf_(c_ctx[k]), s1 = siluf_(c_in[k]), s2 = siluf_(c_in[DM + k]);
                a0 += w * s0; a1 += w * s1; a2 += w * s2;
            }
            LAS f32x4* red = (LAS f32x4*)lds;
            red[(wave * 3 + 0) * 64 + lane] = a0; red[(wave * 3 + 1) * 64 + lane] = a1; red[(wave * 3 + 2) * 64 + lane] = a2;
            __syncthreads();
            if (tid < 192) { const int cnd = tid >> 6, l = tid & 63; f32x4 s = red[cnd * 64 + l];
#pragma unroll
                for (int w = 1; w < 8; ++w) s += red[(w * 3 + cnd) * 64 + l];
                *(f32x4*)(modp + ((size_t)kc * 3 + cnd) * 12288 + slab * 256 + 4 * l) = s; }
        }
    }
    grid.sync();
    }

    for (int rep_ = 0; rep_ < NREP(1); ++rep_) {
    if constexpr ((PHASE_MASK >> 1) & 1)
    {
        const float* const x_prompt = kin(0);
        const float* const x_sample = kin(1);
        const float* const b_ada = kin(9);
        { const int i = wg * NTHR + tid; if (i < 3 * DM) { const int cnd = i / DM, col = i % DM; float s = b_ada[2 * DM + col];
#pragma unroll
                for (int kc = 0; kc < 5; ++kc) s += modp[((size_t)kc * 3 + cnd) * 12288 + 2 * DM + col];
                gatev[i] = s; } }
        LAS float* sh = (LAS float*)lds; LAS float* sc1 = sh + DM;
        int cur_c = -1;
        for (int u = wg; u < 768; u += G) {
            const int cnd = u < 512 ? 0 : (u < 640 ? 1 : 2);
            if (cnd != cur_c) {
                __syncthreads();
                for (int col = tid; col < DM; col += NTHR) { float s = b_ada[col], t = b_ada[DM + col];
#pragma unroll
                    for (int kc = 0; kc < 5; ++kc) { s += modp[((size_t)kc * 3 + cnd) * 12288 + col]; t += modp[((size_t)kc * 3 + cnd) * 12288 + DM + col]; }
                    sh[col] = s; sc1[col] = 1.0f + t; }
                __syncthreads();
                cur_c = cnd;
            }
            const int row = 8 * u + wave;
            const float* xr = (row < NP) ? x_prompt + (size_t)row * DM : x_sample + (size_t)(row - NP) * DM;
            f32x4 v[16]; float s = 0.f;
#pragma unroll
            for (int j = 0; j < 16; ++j) { v[j] = *(const f32x4*)(xr + 4 * lane + 256 * j); s += (v[j][0] + v[j][1]) + (v[j][2] + v[j][3]); }
            const float mean = wave_sum(s) * (1.0f / DM); float s2 = 0.f;
#pragma unroll
            for (int j = 0; j < 16; ++j) { v[j] = v[j] - mean; s2 += (v[j][0] * v[j][0] + v[j][1] * v[j][1]) + (v[j][2] * v[j][2] + v[j][3] * v[j][3]); }
            const float rstd = 1.0f / sqrtf(wave_sum(s2) * (1.0f / DM) + LN_EPS);
            unsigned char* h8 = H8 + (size_t)row * DM; bf16* hr = H + (size_t)row * DM;
#pragma unroll
            for (int j = 0; j < 16; ++j) { const int col = 4 * lane + 256 * j; const f32x4 a = *(const LAS f32x4*)(sc1 + col), b = *(const LAS f32x4*)(sh + col);
                const f32x4 o = v[j] * rstd * a + b; *(unsigned*)(h8 + col) = pk_fp8x4(o[0], o[1], o[2], o[3]);
                if (row < NP) { u32x2 w; w.x = cvt_pk_bf16(o[0], o[1]); w.y = cvt_pk_bf16(o[2], o[3]); *(u32x2*)(hr + col) = w; } }
        }
    }
    GRID_BAR();
    }

    for (int rep_ = 0; rep_ < NREP(2); ++rep_) {
    if constexpr ((PHASE_MASK >> 2) & 1)
    {
        { pg8::Gemm g{(const bf16*)H8, (const bf16*)(WIN8 + (size_t)2816 * DM), MT, INP - 2816, DM / 2}; pg8::StaticOrder S; S.init(MT, INP - 2816, G, wg);
          EpiIn E{CQ, CKVR, KPE, UB, SZA, SZB, SGA, SGB, 0, 11, 1.0f / S_WIN};
          pg8::gemm_phase<EpiIn, pg8::StaticOrder, true, true, true>(lds, g, S, E); }
        __syncthreads();
        { pg8::Gemm g{(const bf16*)(H8 + (size_t)NP * DM), (const bf16*)WIN8, NS, 2816, DM / 2}; pg8::StaticOrder S; S.init(NS, 2816, G, (wg + 32) % G);
          EpiIn E{CQ, CKVR, KPE, UB, SZA, SZB, SGA, SGB, 16, 0, 1.0f / S_WIN};
          pg8::gemm_phase<EpiIn, pg8::StaticOrder, true, true, true>(lds, g, S, E); }
        __syncthreads();
        { pg8::Gemm g{H, WINB, NP, 2816, DM}; pg8::StaticOrder S; S.init(NP, 2816, G, (wg + 200) % G);
          EpiIn E{CQ, CKVR, KPE, UB, SZA, SZB, SGA, SGB, 0, 0, 1.0f};
          pg8::gemm_phase<EpiIn, pg8::StaticOrder, true, true, false>(lds, g, S, E); }
        {
            constexpr int I_UQ = 16 * 48, I_UKV = 8 * 64, I_GLU = 32 * 32, I_PA = 32 * 64, I_PB = 32 * 64, I_O = 64 * 64;
            static_assert(I_UQ + I_UKV + I_GLU + I_PA + I_PB + I_O == 24 * 192 + 56 * 105 + 8, "conversion items vs the idle-workgroup split");
            int cstart = 0, ccnt = 0;
            if (wg >= 232) { cstart = (wg - 232) * 192; ccnt = 192; }
            else if (wg < 56) { cstart = 24 * 192 + wg * 105 + (wg < 8 ? wg : 8); ccnt = 105 + (wg < 8 ? 1 : 0); }
            if (ccnt) {
                const float* const w_uq = kin(12); const float* const w_ukv = kin(14); const float* const w_glu = kin(23);
                const float* const w_pa = kin(25); const float* const w_pb = kin(26); const float* const w_o = kin(27);
                LAS float* scr = (LAS float*)(lds + wave * 16640);
                for (int ii = wave; ii < ccnt; ii += NWAVES) {
                    int r = cstart + ii;
                    if (r < I_UQ) { const int kb = r / 48, nb = r % 48; p0_tile(w_uq, 3072, 64 * kb, 64 * nb, WUQ8, nullptr, S_WUQ, QL, 64 * nb, 0, scr, lane); continue; } r -= I_UQ;
                    if (r < I_UKV) { const int kb = r / 64, nb = r % 64, hh = nb >> 2, jj = nb & 3;
                        p0_tile(w_ukv, 4096, 64 * kb, 64 * nb, (jj < 2) ? WK8 : WV8, nullptr, S_WKV, KVL, hh * 128 + (jj & 1) * 64, 0, scr, lane); continue; } r -= I_UKV;
                    if (r < I_GLU) { const int kb = r / 32, nb = r % 32; p0_tile(w_glu, S5W, 64 * kb, 64 * nb, WGLU8, nullptr, S_WGLU, S5W, 64 * nb, 0, scr, lane); continue; } r -= I_GLU;
                    if (r < I_PA) { const int kb = r / 64, nb = r % 64; p0_tile(w_pa, DM, 64 * kb, 64 * nb, WPAB8, nullptr, S_WP, DM, 64 * nb, 0, scr, lane); continue; } r -= I_PA;
                    if (r < I_PB) { const int kb = r / 64, nb = r % 64; p0_tile(w_pb, DM, 64 * kb, 64 * nb, WPAB8, nullptr, S_WP, DM, 64 * nb, MLAW, scr, lane); continue; } r -= I_PB;
                    { const int kb = r / 64, nb = r % 64; p0_tile(w_o, DM, 64 * kb, 64 * nb, WO8, nullptr, S_WO, DM, 64 * nb, 0, scr, lane); }
                }
            }
        }
    }
    GRID_BAR();
    }

    for (int rep_ = 0; rep_ < NREP(3); ++rep_) {
    if constexpr ((PHASE_MASK >> 3) & 1)
    {
        const float* const st_re = kin(4);
        const float* const st_im = kin(5);
        const float* const g_qn = kin(11);
        const float* const g_kvn = kin(13);
        const float* const s5_a_re = kin(15);
        const float* const s5_a_im = kin(16);
        const float* const s5_log_dt = kin(17);
        const float* const s5_b_re = kin(18);
        const float* const s5_b_im = kin(19);
        const float* const s5_c_re = kin(20);
        const float* const s5_c_im = kin(21);
        const float* const s5_d = kin(22);
#ifndef RMSREP
#define RMSREP 1
#endif
        for (int rrep_ = 0; rrep_ < RMSREP; ++rrep_)
        for (int row = gw; row < MT; row += NGW) {
            {
                f32x4 v[4]; float s = 0.f;
#pragma unroll
                for (int j = 0; j < 4; ++j) { v[j] = *(const f32x4*)(CQ + (size_t)row * QL + 4 * lane + 256 * j); s += (v[j][0] * v[j][0] + v[j][1] * v[j][1]) + (v[j][2] * v[j][2] + v[j][3] * v[j][3]); }
                const float rs = 1.0f / sqrtf(wave_sum(s) * (1.0f / QL) + LN_EPS);
#pragma unroll
                for (int j = 0; j < 4; ++j) { const int col = 4 * lane + 256 * j; const f32x4 gq = *(const f32x4*)(g_qn + col); const f32x4 o = v[j] * rs * gq;
                    *(unsigned*)(CQN8 + (size_t)row * QL + col) = pk_fp8x4(o[0], o[1], o[2], o[3]); }
            }
            {
                f32x4 v[2]; float s = 0.f;
#pragma unroll
                for (int j = 0; j < 2; ++j) { v[j] = *(const f32x4*)(CKVR + (size_t)row * KVL + 4 * lane + 256 * j); s += (v[j][0] * v[j][0] + v[j][1] * v[j][1]) + (v[j][2] * v[j][2] + v[j][3] * v[j][3]); }
                const float rs = 1.0f / sqrtf(wave_sum(s) * (1.0f / KVL) + LN_EPS);
#pragma unroll
                for (int j = 0; j < 2; ++j) { const int col = 4 * lane + 256 * j; const f32x4 gk = *(const f32x4*)(g_kvn + col); const f32x4 o = v[j] * rs * gk;
                    *(unsigned*)(CKV8 + (size_t)row * KVL + col) = pk_fp8x4(o[0], o[1], o[2], o[3]);
                    if (row < NP) *(f32x4*)(out + O_CKV + (size_t)row * KVL + col) = o; }
            }
            {
                const float kv = KPE[(size_t)row * RD + lane]; float o = kv;
                if (row < NP) out[O_KPE + (size_t)row * RD + lane] = kv;
                else { const int t = (row - NP) & 1023; const float pos = (float)((lane < 32) ? (t >> 6) : (t & 63)); const float pv = __shfl_xor(kv, 16);
                    float sn, cs; sincos_acc(pos * rope_inv(lane & 15), sn, cs);
                    o = ((lane & 16) == 0) ? (kv * cs - pv * sn) : (kv * cs + pv * sn); }
                KPEB[(size_t)row * RD + lane] = (bf16)f2bf(o);
            }
        }
        const int vcu = (wg & 7) * (G >> 3) + (wg >> 3);
        LAS unsigned char* wl = lds + wave * S5_WLDS;
#ifndef S5REP
#define S5REP 1
#endif
        for (int s5rep_ = 0; s5rep_ < S5REP; ++s5rep_)
        if (wave < 2) {
            const int id = vcu * 2 + wave;
            if (id < 512) { const int b = id >> 8, g = (id & 255) >> 1, d = id & 1;
                s5_task(UB, YS5 + (size_t)d * MT * S5W, NP + b * 1024, 1024, g, d, s5_a_re, s5_a_im, s5_log_dt, s5_b_re, s5_b_im, s5_c_re, s5_c_im,
                        st_re + ((size_t)(b * 2 + d) * 128 + g) * 64, st_im + ((size_t)(b * 2 + d) * 128 + g) * 64, nullptr, nullptr, wl, lane); }
        } else {
            for (int j = 0; j < 3; ++j) { const int pid = vcu * 6 + (wave - 2) + 1536 * j;
                if (pid < 4096) { const int d = pid & 1, pgi = pid >> 1, b = pgi >> 7, g = pgi & 127;
                    s5_task(UB, YS5 + (size_t)d * MT * S5W, b * 256, 256, g, d, s5_a_re, s5_a_im, s5_log_dt, s5_b_re, s5_b_im, s5_c_re, s5_c_im,
                            nullptr, nullptr, out + O_SRE + ((size_t)(b * 2 + d) * 128 + g) * 64, out + O_SIM + ((size_t)(b * 2 + d) * 128 + g) * 64, wl, lane); } }
        }
        VM_WAIT();
        __syncthreads();
        {
            constexpr int CB = 6;
            auto item_off = [&](int q, size_t& off, int& dcol) -> bool {
                int row0, g, it;
                if (q < 8) { if (vcu >= 256) return false; row0 = NP + (vcu >> 7) * 1024; g = vcu & 127; it = q * NTHR + tid; }
                else { const int r = q - 8, pr2 = r >> 1, pp = pr2 % 3, j = pr2 / 3; const int pgi = vcu * 3 + pp + 768 * j; if (pgi >= 2048) return false; row0 = (pgi >> 7) * 256; g = pgi & 127; it = (r & 1) * NTHR + tid; }
                const int t = it >> 2, q4 = it & 3; dcol = g * 16 + 4 * q4; off = (size_t)(row0 + t) * S5W + dcol; return true; };
#ifndef CMBREP
#define CMBREP 1
#endif
            for (int crep_ = 0; crep_ < CMBREP; ++crep_)
            for (int q0 = 0; q0 < 26; q0 += CB) {
                f32x4 uu[CB], ya[CB], yb[CB], dk[CB]; size_t offs[CB]; bool ok[CB];
#pragma unroll
                for (int e = 0; e < CB; ++e) { int dcol = 0; offs[e] = 0; ok[e] = (q0 + e < 26) && item_off(q0 + e, offs[e], dcol);
                    if (ok[e]) { uu[e] = *(const f32x4*)(UB + offs[e]); ya[e] = *(const f32x4*)(YS5 + offs[e]); yb[e] = *(const f32x4*)(YS5 + (size_t)MT * S5W + offs[e]); dk[e] = *(const f32x4*)(s5_d + dcol); } }
#pragma unroll
                for (int e = 0; e < CB; ++e) if (ok[e]) { const f32x4 y = dk[e] * uu[e] + ya[e] + yb[e];
                    const float g0 = gelu_tanh(y[0]), g1 = gelu_tanh(y[1]), g2 = gelu_tanh(y[2]), g3 = gelu_tanh(y[3]);
                    u32x2 w; w.x = cvt_pk_bf16(g0, g1); w.y = cvt_pk_bf16(g2, g3); *(u32x2*)(Y5 + offs[e]) = w;
                    *(unsigned*)(Y58 + offs[e]) = pk_fp8x4(g0 * S_Y5, g1 * S_Y5, g2 * S_Y5, g3 * S_Y5); }
            }
        }
    }
    GRID_BAR();
    }

    for (int rep_ = 0; rep_ < NREP(4); ++rep_) {
    if constexpr ((PHASE_MASK >> 4) & 1)
    {
        const float* const b_glu = kin(24);
        { ListOrder S{}; if (wg < 192) { S.n = 1; S.pm0 = wg % 24; S.pn0 = wg / 24; }
          pg8::Gemm g{(const bf16*)Y58, (const bf16*)WGLU8, MT, S5W, S5W / 2}; EpiGlu E{Y5, SZB, b_glu, AB8, 1.0f / (S_Y5 * S_WGLU)};
          pg8::gemm_phase<EpiGlu, ListOrder, true, true, true>(lds, g, S, E); }
        __syncthreads();
        { ListOrder S{}; if (wg >= 192) { const int t0 = 2 * (wg - 192); S.n = 2; S.pm0 = t0 % 24; S.pn0 = t0 / 24; S.pm1 = (t0 + 1) % 24; S.pn1 = (t0 + 1) / 24; }
          else if (wg < 160) { const int t0 = 128 + wg; S.n = 1; S.pm0 = t0 % 24; S.pn0 = t0 / 24; }
          pg8::Gemm g{(const bf16*)CQN8, (const bf16*)WUQ8, MT, 3072, QL / 2}; EpiStore E{Q, 3072, 1.0f / S_WUQ};
          pg8::gemm_phase<EpiStore, ListOrder, true, true, true>(lds, g, S, E); }
        __syncthreads();
        const int id0 = (wg >= 160) ? 3 * (wg - 160) : 288 + wg, nid = (wg >= 160) ? 3 : 1;
        { ListOrder S{}; int n = 0;
          for (int k = 0; k < nid; ++k) { const int id = id0 + k; if (id < 224) { const int pm = id % 28, pn = id / 28; if (n == 0) { S.pm0 = pm; S.pn0 = pn; } else if (n == 1) { S.pm1 = pm; S.pn1 = pn; } else { S.pm2 = pm; S.pn2 = pn; } ++n; } }
          S.n = n;
          pg8::Gemm g{(const bf16*)CKV8, (const bf16*)WK8, NKV, 2048, KVL / 2}; EpiStore E{KN, 2048, 1.0f / S_WKV};
          pg8::gemm_phase<EpiStore, ListOrder, true, true, true>(lds, g, S, E); }
        __syncthreads();
        { ListOrder S{}; int n = 0;
          for (int k = 0; k < nid; ++k) { const int id = id0 + k - 224; if (id >= 0) { const int pm = id % 8, pn = id / 8; if (n == 0) { S.pm0 = pm; S.pn0 = pn; } else if (n == 1) { S.pm1 = pm; S.pn1 = pn; } else { S.pm2 = pm; S.pn2 = pn; } ++n; } }
          S.n = n;
          pg8::Gemm g{(const bf16*)WV8, (const bf16*)CKV8, 2048, NKV, KVL / 2}; EpiStore E{VT, NKV, 1.0f / S_WKV};
          pg8::gemm_phase<EpiStore, ListOrder, true, true, true>(lds, g, S, E); }
    }
    GRID_BAR();
    }

    for (int rep_ = 0; rep_ < NREP(5); ++rep_) {
    if constexpr ((PHASE_MASK >> 5) & 1)
    {
        for (int rnd = 0; rnd < 2; ++rnd) {
            int qrow0, h, nt, nt1, key1, key2, rope_t0;
            if (wg < 128) { if (rnd) break; const int b = wg >> 6, hq = wg & 63; h = hq >> 2; const int qb = hq & 3;
                qrow0 = NP + b * 1024 + qb * 256; nt = 24; nt1 = 16; key1 = NP + b * 1024; key2 = MT + b * 512; rope_t0 = qb * 256; }
            else { const int uid = (wg - 128) * 2 + rnd; if (uid >= 256) break; const int b = uid >> 4; h = uid & 15;
                qrow0 = b * 256; nt = 4; nt1 = 4; key1 = b * 256; key2 = 0; rope_t0 = -1; }
            attn_unit(Q, KN, KPEB, VT, SZA, AB8, qrow0, h, nt, nt1, key1, key2, rope_t0, lds, tid, wave, lane);
            __syncthreads();
        }
    }
    GRID_BAR();
    }

    if constexpr ((PHASE_MASK >> 6) & 1)
    {
        const float* const x_prompt = kin(0);
        const float* const x_sample = kin(1);
        const int x = wg & 7, i = wg >> 3, pl = i & 3, cl = i >> 2;
        const pg8::Gemm g6{(const bf16*)AB8, (const bf16*)WPAB8, MT, DM, DM / 2}; const EpiMerge E6{SGA, SGB, MG8, S_MG / (S_AB * S_WP)};
        const pg8::Gemm g7{(const bf16*)MG8, (const bf16*)WO8, MT, DM, DM / 2}; const EpiOut E7{x_prompt, x_sample, gatev, out, 1.0f / (S_MG * S_WO)};
        { ListOrder S{}; S.n = 1; S.pm0 = 4 * (x >> 1) + pl; S.pn0 = 8 * (x & 1) + cl;
          pg8::gemm_phase<EpiMerge, ListOrder, true, true, true>(lds, g6, S, E6); }
        GRID_BAR();
        if (x < 4) { ListOrder S{}; S.n = 1; S.pm0 = 16 + 4 * (x >> 1) + pl; S.pn0 = 8 * (x & 1) + cl;
          pg8::gemm_phase<EpiMerge, ListOrder, true, true, true>(lds, g6, S, E6); }
        else { const int y = x - 4; ListOrder S{}; S.n = 1; S.pm0 = 4 * (y >> 1) + pl; S.pn0 = 8 * (y & 1) + cl;
          pg8::gemm_phase<EpiOut, ListOrder, true, true, true>(lds, g7, S, E7); }
        GRID_BAR();
        { ListOrder S{}; S.n = 1; S.pm0 = 8 + 4 * (x >> 1) + pl; S.pn0 = 8 * (x & 1) + cl;
          pg8::gemm_phase<EpiOut, ListOrder, true, true, true>(lds, g7, S, E7); }
    }
    GRID_BAR();

    if constexpr ((PHASE_MASK >> 8) & 1)
    {
        const float* const ln_g = kin(28);
        const float* const ln_b = kin(29);
    for (int row = gw; row < MT; row += NGW) {
        float* zr = out + (size_t)row * DM;
        f32x4 v[16]; float s = 0.f;
#pragma unroll
        for (int j = 0; j < 16; ++j) { v[j] = *(const f32x4*)(zr + 4 * lane + 256 * j); s += (v[j][0] + v[j][1]) + (v[j][2] + v[j][3]); }
        const float mean = wave_sum(s) * (1.0f / DM); float s2 = 0.f;
#pragma unroll
        for (int j = 0; j < 16; ++j) { v[j] = v[j] - mean; s2 += (v[j][0] * v[j][0] + v[j][1] * v[j][1]) + (v[j][2] * v[j][2] + v[j][3] * v[j][3]); }
        const float rstd = 1.0f / sqrtf(wave_sum(s2) * (1.0f / DM) + LN_EPS);
#pragma unroll
        for (int j = 0; j < 16; ++j) { const int col = 4 * lane + 256 * j; const f32x4 gg = *(const f32x4*)(ln_g + col), bb = *(const f32x4*)(ln_b + col);
            *(f32x4*)(zr + col) = v[j] * rstd * gg + bb; }
    }
    }
}

#undef out
#undef modp
#undef gatev
#undef WIN8
#undef WINB
#undef WUQ8
#undef WK8
#undef WV8
#undef WGLU8
#undef WPAB8
#undef WO8
#undef H8
#undef H
#undef CQ
#undef CKVR
#undef KPE
#undef UB
#undef SZA
#undef SZB
#undef SGA
#undef SGB
#undef CQN8
#undef CKV8
#undef KPEB
#undef Q
#undef KN
#undef VT
#undef YS5
#undef Y5
#undef Y58
#undef AB8
#undef MG8
extern "C" void kernel_launch(void* const* d_in, const int* in_sizes, int n_in, void* d_out, int out_size, void* d_ws, size_t ws_size, hipStream_t stream) {
    static int grid = 0;
    if (grid == 0) {
        if (n_in != 30 || ws_size < WS_END) { fprintf(stderr, "kernel_launch: need 30 inputs and %zu bytes of workspace; got %d, %zu\n", (size_t)WS_END, n_in, ws_size); grid = -1; return; }
        int dev = 0, cus = 0, per_cu = 0;
        hipGetDevice(&dev); hipDeviceGetAttribute(&cus, hipDeviceAttributeMultiprocessorCount, dev);
        if (hipFuncSetAttribute((const void*)hybrid_fwd, hipFuncAttributeMaxDynamicSharedMemorySize, LDS_BYTES) != hipSuccess) { fprintf(stderr, "kernel_launch: hipFuncSetAttribute failed\n"); grid = -1; return; }
        hipOccupancyMaxActiveBlocksPerMultiprocessor(&per_cu, (const void*)hybrid_fwd, NTHR, LDS_BYTES);
        (void)hipGetLastError();
        if (per_cu < 1) { fprintf(stderr, "kernel_launch: occupancy query says %d blocks per CU\n", per_cu); per_cu = 1; }
        grid = cus;
        if (grid != 256) { fprintf(stderr, "kernel_launch: built for a 256-CU device (got %d)\n", cus); grid = -1; return; }
    }
    if (grid < 0) return;
    if (hipMemsetAsync((char*)d_ws + WS_CTL, 0, CTL_ZERO_BYTES, stream) != hipSuccess) { fprintf(stderr, "kernel_launch: memset failed\n"); return; }
    Params p{};
    for (int i = 0; i < 30; ++i) p.in[i] = (const float*)d_in[i];
    p.out = (float*)d_out; p.ws = (unsigned char*)d_ws;
    void* args[] = {&p};
    hipError_t e = hipLaunchCooperativeKernel((const void*)hybrid_fwd, dim3(grid), dim3(NTHR), args, LDS_BYTES, stream);
    if (e != hipSuccess) fprintf(stderr, "cooperative launch failed: %s (grid %d)\n", hipGetErrorString(e), grid);
}
```
